# Optimizing an MI355X kernel written in HIP

```python
import numpy as np
import jax
import jax.numpy as jnp
from jax import lax

D_MODEL = 1024
BATCH = 32
SEQ = 2048
DEPTH = 2

HEAD_DIM = 64
RET_WIDTH = D_MODEL // 4
RET_HEADS = RET_WIDTH // HEAD_DIM
RET_CHUNK = 128
CONV_WIDTH = D_MODEL // 4
CONV_K = 3
NSA_WIDTH = D_MODEL // 2
NSA_HEADS = NSA_WIDTH // HEAD_DIM
NSA_KV_GROUPS = 2
NSA_HPG = NSA_HEADS // NSA_KV_GROUPS
NSA_KV_WIDTH = NSA_KV_GROUPS * HEAD_DIM
CMP_LEN = 32
CMP_STRIDE = 16
SLC_LEN = 64
SLC_TOPK = 8
SLC_QBLOCK = 32
WIN_LEN = 256
WIN_QBLOCK = 128
MIX_WIDTH = RET_WIDTH + CONV_WIDTH + NSA_WIDTH
D_FF = 4 * D_MODEL
XPOS_BASE = 10000.0
EPS = 1e-6
NEG_INF = -1e30
FORCE_BONUS = 1e4
IN_WIDTHS = (RET_WIDTH,) * 4 + (CONV_WIDTH,) * 3 + (NSA_WIDTH,) + (NSA_KV_WIDTH,) * 6 + (3 * NSA_HEADS,)
IN_WIDTH = sum(IN_WIDTHS)

kernel_name = 'hybrid_retnet_shortconv_nsa_block'


def rms_norm(x, gain=None):
    xf = x.astype(jnp.float32)
    y = xf * lax.rsqrt(jnp.mean(xf * xf, axis=-1, keepdims=True) + EPS)
    if gain is not None:
        y = y * gain.astype(jnp.float32)
    return y.astype(x.dtype)


def masked_softmax(scores, mask):
    s = jnp.where(mask, scores.astype(jnp.float32), NEG_INF)
    p = jnp.exp(s - jnp.max(s, axis=-1, keepdims=True)) * mask
    return p / jnp.maximum(jnp.sum(p, axis=-1, keepdims=True), 1e-30)


def xpos_rotate(x, cos, sin):
    x1 = x[..., 0::2]
    x2 = x[..., 1::2]
    rot = jnp.stack((-x2, x1), axis=-1).reshape(x.shape)
    return x * cos + rot * sin


def retention(q, k, v, g):
    b, s, _ = q.shape
    h, d, c = RET_HEADS, HEAD_DIM, RET_CHUNK
    n = s // c
    pos = jnp.arange(s, dtype=jnp.float32)
    inv_freq = 1.0 / (XPOS_BASE ** jnp.linspace(0.0, 1.0, d // 2, dtype=jnp.float32))
    ang = jnp.repeat(pos[:, None] * inv_freq[None, :], 2, axis=-1)[:, None, :]
    cos = jnp.cos(ang).astype(q.dtype)
    sin = jnp.sin(ang).astype(q.dtype)
    qh = xpos_rotate(q.reshape(b, s, h, d), cos, sin)
    kh = xpos_rotate(k.reshape(b, s, h, d), cos, sin) * (d ** -0.5)

    def to_chunks(t):
        return t.reshape(b, n, c, h, d).transpose(0, 3, 1, 2, 4)

    qc, kc, vc = to_chunks(qh), to_chunks(kh), to_chunks(v.reshape(b, s, h, d))
    log_gamma = jnp.log(1.0 - 2.0 ** (-5.0 - jnp.arange(h, dtype=jnp.float32)))
    idx = jnp.arange(c, dtype=jnp.float32)
    rel = idx[:, None] - idx[None, :]
    intra_decay = jnp.where(rel >= 0, jnp.exp(log_gamma[:, None, None] * jnp.maximum(rel, 0.0)), 0.0)
    scores = jnp.einsum('bhncd,bhnmd->bhncm', qc, kc) * intra_decay[:, None]
    intra = jnp.einsum('bhncm,bhnmd->bhncd', scores, vc)
    k_decay = jnp.exp(log_gamma[:, None] * (c - 1.0 - idx))[:, None, :, None]
    q_decay = jnp.exp(log_gamma[:, None] * (idx + 1.0))[:, None, :, None]
    chunk_decay = jnp.exp(log_gamma * c)[:, None, None]
    kv = jnp.einsum('bhncd,bhnce->nbhde', kc * k_decay, vc)

    def step(state, kv_n):
        return state * chunk_decay + kv_n, state

    _, prev = lax.scan(step, jnp.zeros(kv.shape[1:], kv.dtype), kv)
    cross = jnp.einsum('bhncd,nbhde->bhnce', qc * q_decay, prev)
    o = (intra + cross).transpose(0, 2, 3, 1, 4).reshape(b, s, h, d)
    o = rms_norm(o).reshape(b, s, h * d)
    return (jax.nn.silu(g) * o).astype(q.dtype)


def short_conv(b_gate, c_gate, h_in, conv_w):
    u = c_gate * h_in
    y = lax.conv_general_dilated(u, conv_w[:, None, :].astype(u.dtype), window_strides=(1,),
                                 padding=[(CONV_K - 1, 0)], dimension_numbers=('NWC', 'WIO', 'NWC'),
                                 feature_group_count=u.shape[-1])
    return b_gate * y


def nsa(q, k_c, v_c, k_s, v_s, k_w, v_w, gate_logits, q_gain, k_gain,
        pe_k, w1_k, w2_k, pe_v, w1_v, w2_v):
    b, s, _ = q.shape
    G, hpg, d = NSA_KV_GROUPS, NSA_HPG, HEAD_DIM
    qh = rms_norm(q.reshape(b, s, G, hpg, d), q_gain) * (d ** -0.5)
    qh = qh.transpose(0, 2, 3, 1, 4)
    t_pos = jnp.arange(s)

    def kv_heads(t):
        return t.reshape(b, s, G, d)

    n_cmp = (s - CMP_LEN) // CMP_STRIDE + 1
    win_idx = np.arange(n_cmp)[:, None] * CMP_STRIDE + np.arange(CMP_LEN)[None, :]

    def compress(t, pe, w1, w2):
        blocks = kv_heads(t)[:, win_idx] + pe[None, None, :, None, :]
        flat = blocks.transpose(0, 1, 3, 2, 4).reshape(b, n_cmp, G, CMP_LEN * d)
        return jax.nn.silu(flat @ w1) @ w2

    k_cmp = rms_norm(compress(k_c, pe_k, w1_k, w2_k), k_gain)
    v_cmp = compress(v_c, pe_v, w1_v, w2_v)
    cmp_end = jnp.arange(n_cmp) * CMP_STRIDE + CMP_LEN - 1
    cmp_mask = cmp_end[None, :] <= t_pos[:, None]
    p_cmp = masked_softmax(jnp.einsum('bghsd,bngd->bghsn', qh, k_cmp), cmp_mask)
    o_cmp = jnp.einsum('bghsn,bngd->bghsd', p_cmp.astype(v_cmp.dtype), v_cmp)

    n_slc = s // SLC_LEN
    n_sel = min(SLC_TOPK, n_slc)
    cs = np.arange(n_cmp)[:, None] * CMP_STRIDE
    ss = np.arange(n_slc)[None, :] * SLC_LEN
    overlap = np.clip(np.minimum(cs + CMP_LEN, ss + SLC_LEN) - np.maximum(cs, ss), 0, None)
    overlap = jnp.asarray(overlap.astype(np.float32) / CMP_LEN)
    imp = jnp.einsum('bghsn,nj->bgsj', p_cmp, overlap)
    t_blk = t_pos // SLC_LEN
    j = jnp.arange(n_slc)
    eligible = j[None, :] <= t_blk[:, None]
    forced = (j[None, :] == 0) | (j[None, :] == t_blk[:, None]) | (j[None, :] == t_blk[:, None] - 1)
    sel_score = jnp.where(eligible, imp + FORCE_BONUS * forced, -1.0)
    _, sel_idx = lax.top_k(sel_score, n_sel)

    ks_blk = rms_norm(kv_heads(k_s), k_gain).transpose(0, 2, 1, 3).reshape(b, G, n_slc, SLC_LEN, d)
    vs_blk = kv_heads(v_s).transpose(0, 2, 1, 3).reshape(b, G, n_slc, SLC_LEN, d)
    gather = jax.vmap(jax.vmap(lambda blocks, ix: blocks[ix]))
    nq = s // SLC_QBLOCK
    n_keys = n_sel * SLC_LEN
    q_sw = qh.reshape(b, G, hpg, nq, SLC_QBLOCK, d).transpose(3, 0, 1, 2, 4, 5)
    idx_sw = sel_idx.reshape(b, G, nq, SLC_QBLOCK, n_sel).transpose(2, 0, 1, 3, 4)

    def sel_block(args):
        q_b, idx_b, blk = args
        t = blk * SLC_QBLOCK + jnp.arange(SLC_QBLOCK)
        k_g = gather(ks_blk, idx_b).reshape(b, G, SLC_QBLOCK, n_keys, d)
        v_g = gather(vs_blk, idx_b).reshape(b, G, SLC_QBLOCK, n_keys, d)
        key_pos = (idx_b[..., None] * SLC_LEN + jnp.arange(SLC_LEN)).reshape(b, G, SLC_QBLOCK, n_keys)
        mask = (key_pos <= t[:, None])[:, :, None]
        p = masked_softmax(jnp.einsum('bghqd,bgqkd->bghqk', q_b, k_g), mask)
        return jnp.einsum('bghqk,bgqkd->bghqd', p.astype(v_g.dtype), v_g)

    o_slc = lax.map(sel_block, (q_sw, idx_sw, jnp.arange(nq)))
    o_slc = o_slc.transpose(1, 2, 3, 0, 4, 5).reshape(b, G, hpg, s, d)

    nb = s // WIN_QBLOCK
    nw = WIN_LEN // WIN_QBLOCK

    def band(t):
        tp = jnp.pad(t.transpose(0, 2, 1, 3), ((0, 0), (0, 0), (WIN_LEN, 0), (0, 0)))
        tp = tp.reshape(b, G, nb + nw, WIN_QBLOCK, d)
        return jnp.concatenate([tp[:, :, i:i + nb] for i in range(nw + 1)], axis=3)

    kw_band = band(rms_norm(kv_heads(k_w), k_gain))
    vw_band = band(kv_heads(v_w))
    q_win = qh.reshape(b, G, hpg, nb, WIN_QBLOCK, d)
    qpos = jnp.arange(nb)[:, None] * WIN_QBLOCK + jnp.arange(WIN_QBLOCK)[None, :]
    kpos = jnp.arange(nb)[:, None] * WIN_QBLOCK - WIN_LEN + jnp.arange((nw + 1) * WIN_QBLOCK)[None, :]
    kp = kpos[:, None, :]
    qp = qpos[:, :, None]
    win_mask = (kp <= qp) & (kp > qp - WIN_LEN) & (kp >= 0)
    p_win = masked_softmax(jnp.einsum('bghiqd,bgikd->bghiqk', q_win, kw_band), win_mask)
    o_win = jnp.einsum('bghiqk,bgikd->bghiqd', p_win.astype(vw_band.dtype), vw_band).reshape(b, G, hpg, s, d)

    gates = jax.nn.sigmoid(gate_logits.astype(jnp.float32)).reshape(b, s, NSA_HEADS, 3).astype(q.dtype)

    def to_bshd(o):
        return o.transpose(0, 3, 1, 2, 4).reshape(b, s, NSA_HEADS, d)

    o = (gates[..., 0:1] * to_bshd(o_cmp) + gates[..., 1:2] * to_bshd(o_slc)
         + gates[..., 2:3] * to_bshd(o_win))
    return o.reshape(b, s, NSA_WIDTH)


def setup_inputs(seed: int = 0) -> dict:
    key = jax.random.key(seed)
    ks = jax.random.split(key, 18)
    f32 = jnp.float32

    def nrm(k, shape, scale):
        return jax.random.normal(k, shape, f32) * scale

    return {
        'x': nrm(ks[0], (BATCH, SEQ, D_MODEL), 1.0),
        'norm_mix': 1.0 + nrm(ks[1], (DEPTH, D_MODEL), 0.05),
        'w_in': nrm(ks[2], (DEPTH, D_MODEL, IN_WIDTH), D_MODEL ** -0.5),
        'conv_w': nrm(ks[3], (DEPTH, CONV_K, CONV_WIDTH), CONV_K ** -0.5),
        'nsa_q_norm': 1.0 + nrm(ks[4], (DEPTH, HEAD_DIM), 0.05),
        'nsa_k_norm': 1.0 + nrm(ks[5], (DEPTH, HEAD_DIM), 0.05),
        'cmp_pe_k': nrm(ks[6], (DEPTH, CMP_LEN, HEAD_DIM), 0.1),
        'cmp_w1_k': nrm(ks[7], (DEPTH, CMP_LEN * HEAD_DIM, HEAD_DIM), (CMP_LEN * HEAD_DIM) ** -0.5),
        'cmp_w2_k': nrm(ks[8], (DEPTH, HEAD_DIM, HEAD_DIM), HEAD_DIM ** -0.5),
        'cmp_pe_v': nrm(ks[9], (DEPTH, CMP_LEN, HEAD_DIM), 0.1),
        'cmp_w1_v': nrm(ks[10], (DEPTH, CMP_LEN * HEAD_DIM, HEAD_DIM), (CMP_LEN * HEAD_DIM) ** -0.5),
        'cmp_w2_v': nrm(ks[11], (DEPTH, HEAD_DIM, HEAD_DIM), HEAD_DIM ** -0.5),
        'w_out': nrm(ks[12], (DEPTH, MIX_WIDTH, D_MODEL), MIX_WIDTH ** -0.5),
        'norm_mlp': 1.0 + nrm(ks[13], (DEPTH, D_MODEL), 0.05),
        'w_up': nrm(ks[14], (DEPTH, D_MODEL, D_FF), D_MODEL ** -0.5),
        'w_down': nrm(ks[15], (DEPTH, D_FF, D_MODEL), D_FF ** -0.5),
    }


def reference(x, norm_mix, w_in, conv_w, nsa_q_norm, nsa_k_norm, cmp_pe_k, cmp_w1_k, cmp_w2_k,
              cmp_pe_v, cmp_w1_v, cmp_w2_v, w_out, norm_mlp, w_up, w_down):
    split_points = [int(v) for v in np.cumsum(IN_WIDTHS)[:-1]]
    for l in range(DEPTH):
        h = rms_norm(x, norm_mix[l])
        z = jnp.einsum('bsd,de->bse', h, w_in[l])
        (r_q, r_k, r_v, r_g, c_b, c_c, c_h, n_q, n_kc, n_vc, n_ks, n_vs, n_kw, n_vw, n_g) = jnp.split(
            z, split_points, axis=-1)
        y_ret = retention(r_q, r_k, r_v, r_g)
        y_conv = short_conv(c_b, c_c, c_h, conv_w[l])
        y_nsa = nsa(n_q, n_kc, n_vc, n_ks, n_vs, n_kw, n_vw, n_g, nsa_q_norm[l], nsa_k_norm[l],
                    cmp_pe_k[l], cmp_w1_k[l], cmp_w2_k[l], cmp_pe_v[l], cmp_w1_v[l], cmp_w2_v[l])
        mixed = jnp.concatenate([y_ret, y_conv, y_nsa], axis=-1)
        x = x + jnp.einsum('bse,ed->bsd', mixed, w_out[l])
        h = rms_norm(x, norm_mlp[l])
        x = x + jnp.einsum('bsf,fd->bsd', jnp.square(jax.nn.relu(jnp.einsum('bsd,df->bsf', h, w_up[l]))), w_down[l])
    return x
```

```cpp
#include <hip/hip_runtime.h>
#include <hip/hip_cooperative_groups.h>
#include <cstdio>
#include <cstdint>
namespace cg = cooperative_groups;

#define LAS __attribute__((address_space(3)))
typedef unsigned short bf16_t;
typedef short bf16x8 __attribute__((ext_vector_type(8)));
typedef float f32x4 __attribute__((ext_vector_type(4)));
typedef unsigned u32x4 __attribute__((ext_vector_type(4)));
typedef unsigned u32x2 __attribute__((ext_vector_type(2)));

template <int K> __device__ __forceinline__ float swz_f(float v) { return __builtin_bit_cast(float, __builtin_amdgcn_ds_swizzle(__builtin_bit_cast(int, v), (K << 10) | 0x1f)); }
template <int K> __device__ __forceinline__ unsigned swz_u(unsigned v) { return (unsigned)__builtin_amdgcn_ds_swizzle((int)v, (K << 10) | 0x1f); }
__device__ __forceinline__ float x32_sum(float v) { const auto rr = __builtin_amdgcn_permlane32_swap(__float_as_uint(v), __float_as_uint(v), false, false); return __uint_as_float(rr[0]) + __uint_as_float(rr[1]); }
__device__ __forceinline__ float x32_max(float v) { const auto rr = __builtin_amdgcn_permlane32_swap(__float_as_uint(v), __float_as_uint(v), false, false); return fmaxf(__uint_as_float(rr[0]), __uint_as_float(rr[1])); }
__device__ __forceinline__ unsigned x32_or(unsigned v) { const auto rr = __builtin_amdgcn_permlane32_swap(v, v, false, false); return rr[0] | rr[1]; }
namespace pg8 {
#define PG8_LAS __attribute__((address_space(3)))
constexpr int BM = 256, BK = 64, HALF = 128, HTB = HALF * BK * 2, STAGE_BYTES = 8 * HTB, NXCD = 8, WGM = 8;
__host__ __device__ __forceinline__ int lds_byte(int r, int c) { const int st = (r >> 4) * 2 + (c >> 5), rr = r & 15, cc = c & 31, ob = rr * 64 + cc * 2; return st * 1024 + (ob ^ (((ob >> 9) & 1) << 5)); }
__host__ __device__ __forceinline__ void stage_rc(int b, int& R, int& C) { const int st = b / 1024, sb = b % 1024, swz = sb ^ (((sb >> 9) & 1) << 5); R = (st >> 1) * 16 + swz / 64; C = (st & 1) * 32 + (swz % 64) / 2; }
__host__ __device__ __forceinline__ int perm32(int rho) { const int n = rho >> 4, i = rho & 15; return 8 * (i >> 2) + 4 * n + (i & 3); }
struct Unit { int pm, pn; };
struct Gemm { const bf16_t* A; const bf16_t* Bt; int M, N, K; };
struct StaticOrder {
    int nM, nN, nwg, G, c;
    __host__ __device__ void init(int M, int N, int G_, int c_) { nM = M / BM; nN = N / BM; nwg = nM * nN; G = G_; c = c_; }
    __host__ __device__ bool next(int i, Unit& u) const {
        const long L = (long)i * G + c; if (L >= nwg) return false;
        int wgid = (int)L; { const int q = nwg / NXCD, r = nwg % NXCD, xcd = wgid % NXCD, off = wgid / NXCD; wgid = (xcd < r ? xcd * (q + 1) : r * (q + 1) + (xcd - r) * q) + off; }
        const int nig = WGM * nN, gid = wgid / nig, fm = gid * WGM, gsz = (nM - fm) < WGM ? (nM - fm) : WGM;
        u.pm = fm + ((wgid % nig) % gsz); u.pn = (wgid % nig) / gsz; return true;
    }
    __device__ __forceinline__ void a_ready(const Unit&) const {}
    __device__ __forceinline__ void done(const Unit&) const {}
};
typedef float f32x2_t __attribute__((ext_vector_type(2))); typedef __bf16 bf16x2_t __attribute__((ext_vector_type(2)));
__device__ __forceinline__ unsigned cvt_pk_bf16(float lo, float hi) { const f32x2_t v = {lo, hi}; const bf16x2_t b = __builtin_convertvector(v, bf16x2_t); return __builtin_bit_cast(unsigned, b); }

template <int ACT> struct EpiBf16 {
    static constexpr bool PERM = true, AFTER_DRAIN = false, HAS_PRE = true;
    bf16_t* O; int ldc; const float* ssq;
    struct Pre { f32x4 s0, s1, s2, s3; };
    __device__ __forceinline__ Pre pre_load(int pm, int tid) const { Pre p; const f32x4* sp = (const f32x4*)(ssq + (size_t)(pm * BM + (tid & 255)) * 16); p.s0 = sp[0]; p.s1 = sp[1]; p.s2 = sp[2]; p.s3 = sp[3]; return p; }
    __device__ __forceinline__ void pre_store(const Pre& p, PG8_LAS float* tab, int tid) const {
        const float tot = ((p.s0[0] + p.s0[1]) + (p.s0[2] + p.s0[3])) + ((p.s1[0] + p.s1[1]) + (p.s1[2] + p.s1[3])) + ((p.s2[0] + p.s2[1]) + (p.s2[2] + p.s2[3])) + ((p.s3[0] + p.s3[1]) + (p.s3[2] + p.s3[3]));
        if (tid < 256) tab[tid] = rsqrtf(tot * (1.0f / 1024.0f) + 1e-6f);
    }
    __device__ __forceinline__ void operator()(const f32x4 (&acc)[2][2][4][2], const Unit& u, int wr, int wc, int fr, int fq, const PG8_LAS float* tab) const {
        const int rl0 = wr * 64 + fr; const int row0 = u.pm * BM + rl0; const int col0 = u.pn * BM + wc * 32 + 8 * fq;
#pragma unroll
        for (int ai = 0; ai < 2; ++ai)
#pragma unroll
            for (int m = 0; m < 4; ++m) { const int row = row0 + ai * HALF + m * 16; bf16_t* rowp = O + (size_t)row * ldc + col0;
                const float rstd = tab[rl0 + ai * HALF + m * 16];
#pragma unroll
                for (int bj = 0; bj < 2; ++bj) { f32x4 v0 = acc[ai][bj][m][0] * rstd, v1 = acc[ai][bj][m][1] * rstd;
                    if (ACT == 1) {
#pragma unroll
                        for (int e = 0; e < 4; ++e) { float a = v0[e] > 0.f ? v0[e] : 0.f; v0[e] = a * a; float b = v1[e] > 0.f ? v1[e] : 0.f; v1[e] = b * b; } }
                    u32x4 w; w.x = cvt_pk_bf16(v0[0], v0[1]); w.y = cvt_pk_bf16(v0[2], v0[3]); w.z = cvt_pk_bf16(v1[0], v1[1]); w.w = cvt_pk_bf16(v1[2], v1[3]);
                    *(u32x4*)(rowp + bj * HALF) = w; } }
    }
};
struct EpiRes {
    static constexpr bool PERM = true, AFTER_DRAIN = false, HAS_PRE = false;
    const float* base; float* out; int ldc; bf16_t* xb; float* ssq;
    __device__ __forceinline__ void operator()(const f32x4 (&acc)[2][2][4][2], const Unit& u, int wr, int wc, int fr, int fq, const PG8_LAS float*) const {
        const int row0 = u.pm * BM + wr * 64 + fr; const int col0 = u.pn * BM + wc * 32 + 8 * fq;
#pragma unroll
        for (int ai = 0; ai < 2; ++ai)
#pragma unroll
            for (int m = 0; m < 4; ++m) { const int row = row0 + ai * HALF + m * 16; const size_t off = (size_t)row * ldc + col0; float ss = 0.f;
#pragma unroll
                for (int bj = 0; bj < 2; ++bj) {
                    const f32x4 b0 = *(const f32x4*)(base + off + bj * HALF), b1 = *(const f32x4*)(base + off + bj * HALF + 4);
                    const f32x4 v0 = b0 + acc[ai][bj][m][0], v1 = b1 + acc[ai][bj][m][1];
                    *(f32x4*)(out + off + bj * HALF) = v0; *(f32x4*)(out + off + bj * HALF + 4) = v1;
                    if (xb) { u32x4 w; w.x = cvt_pk_bf16(v0[0], v0[1]); w.y = cvt_pk_bf16(v0[2], v0[3]); w.z = cvt_pk_bf16(v1[0], v1[1]); w.w = cvt_pk_bf16(v1[2], v1[3]);
                        *(u32x4*)(xb + off + bj * HALF) = w;
                        ss += ((v0[0] * v0[0] + v0[1] * v0[1]) + (v0[2] * v0[2] + v0[3] * v0[3])) + ((v1[0] * v1[0] + v1[1] * v1[1]) + (v1[2] * v1[2] + v1[3] * v1[3])); } }
                if (xb) { ss += __shfl_xor(ss, 16); ss += __shfl_xor(ss, 32); if (fq == 0) ssq[(size_t)row * 16 + u.pn * 4 + wc] = ss; } }
    }
};

template <class Epi, class Sched, bool ALIGN_EPI = false, bool SP2 = false>
__device__ __forceinline__ void gemm_phase(PG8_LAS unsigned char* lds, const Gemm g, const Sched& S, const Epi& E) {
    int tid_ = threadIdx.x; asm volatile("" : "+v"(tid_));
    const int tid = tid_, wid = __builtin_amdgcn_readfirstlane(tid >> 6), lane = tid & 63, wr = wid >> 2, wc = wid & 3, fr = lane & 15, fq = lane >> 4;
    const int K = g.K, nt = K / BK;
    unsigned voffA[2], voffB[2];
#pragma unroll
    for (int i = 0; i < 2; ++i) { int R, C; stage_rc(tid * 16 + i * 8192, R, C); const int Rb = Epi::PERM ? ((R & ~31) + perm32(R & 31)) : R;
        voffA[i] = (unsigned)(R * K + C) * 2u; voffB[i] = (unsigned)(Rb * K + C) * 2u; }
    const size_t kstep = (size_t)(BK * 2);
    const size_t hstep = (size_t)HALF * K * 2;
    const size_t tstep = 2 * hstep;
    const unsigned ldsw = (unsigned)wid * 1024u;
    const int aoff = lds_byte(wr * 64 + fr, fq * 8), boff = lds_byte(wc * 32 + fr, fq * 8);
#define PG8_SA(b, h) (((b) * 2 + (h)) * HTB)
#define PG8_SB(b, h) ((4 + (b) * 2 + (h)) * HTB)
#define PG8_STAGE(bufoff, gbase, voff) do { _Pragma("unroll") for (int _i = 0; _i < 2; ++_i) \
        __builtin_amdgcn_global_load_lds((const unsigned*)((const char*)(gbase) + (voff)[_i]), (PG8_LAS unsigned*)(lds + (bufoff) + ldsw + _i * 8192), 16, 0, 0); } while (0)
#define PG8_LDA(dst, b, h) do { _Pragma("unroll") for (int m = 0; m < 4; ++m) _Pragma("unroll") for (int k = 0; k < 2; ++k) dst[m][k] = *(const PG8_LAS bf16x8*)(lds + PG8_SA(b, h) + aoff + m * 2048 + k * 1024); } while (0)
#define PG8_LDB(dst, b, h) do { _Pragma("unroll") for (int n = 0; n < 2; ++n) _Pragma("unroll") for (int k = 0; k < 2; ++k) dst[n][k] = *(const PG8_LAS bf16x8*)(lds + PG8_SB(b, h) + boff + n * 2048 + k * 1024); } while (0)
#define PG8_MMA(ai, bj, At, Bt) do { __builtin_amdgcn_s_setprio(1); _Pragma("unroll") for (int m = 0; m < 4; ++m) _Pragma("unroll") for (int n = 0; n < 2; ++n) _Pragma("unroll") for (int k = 0; k < 2; ++k) \
        acc[ai][bj][m][n] = __builtin_amdgcn_mfma_f32_16x16x32_bf16(Bt[n][k], At[m][k], acc[ai][bj][m][n], 0, 0, 0); __builtin_amdgcn_s_setprio(0); } while (0)
#define PG8_WAIT_V(n) asm volatile("s_waitcnt vmcnt(" #n ")" ::: "memory")
#define PG8_WAIT_L(n) asm volatile("s_waitcnt lgkmcnt(" #n ")" ::: "memory")
#define PG8_BAR __builtin_amdgcn_s_barrier()
#define PG8_SCHED __builtin_amdgcn_sched_barrier(0)
    Unit cur, nxt; int ui = 0;
    if (!S.next(0, cur)) return;
    f32x4 acc[2][2][4][2];
#pragma unroll
    for (int a = 0; a < 2; ++a)
#pragma unroll
        for (int b = 0; b < 2; ++b)
#pragma unroll
            for (int m = 0; m < 4; ++m)
#pragma unroll
                for (int n = 0; n < 2; ++n) acc[a][b][m][n] = (f32x4){0.f, 0.f, 0.f, 0.f};
    bf16x8 At[4][2], B0[2][2], B1[2][2];
    const char* cA = (const char*)g.A + (size_t)cur.pm * tstep; const char* cB = (const char*)g.Bt + (size_t)cur.pn * tstep;
    S.a_ready(cur);
    PG8_LAS float* ptab = (PG8_LAS float*)(lds + STAGE_BYTES);
    if constexpr (Epi::HAS_PRE) { const auto p0 = E.pre_load(cur.pm, tid); E.pre_store(p0, ptab, tid); }
    if constexpr (SP2) {
        PG8_STAGE(PG8_SB(0, 0), cB, voffB); PG8_STAGE(PG8_SB(0, 1), cB + hstep, voffB); PG8_STAGE(PG8_SA(0, 0), cA, voffA); PG8_STAGE(PG8_SA(0, 1), cA + hstep, voffA);
        if (wr == 1) PG8_BAR;
        PG8_WAIT_V(2); PG8_BAR;
        PG8_STAGE(PG8_SB(1, 0), cB + kstep, voffB); PG8_STAGE(PG8_SA(1, 0), cA + kstep, voffA); PG8_STAGE(PG8_SB(1, 1), cB + hstep + kstep, voffB);
        PG8_WAIT_V(6); PG8_BAR;
    } else {
        PG8_STAGE(PG8_SB(0, 0), cB, voffB); PG8_STAGE(PG8_SA(0, 0), cA, voffA); PG8_STAGE(PG8_SB(0, 1), cB + hstep, voffB); PG8_STAGE(PG8_SA(0, 1), cA + hstep, voffA);
        if (wr == 1) PG8_BAR;
        PG8_WAIT_V(4); PG8_BAR;
        PG8_STAGE(PG8_SB(1, 0), cB + kstep, voffB); PG8_STAGE(PG8_SA(1, 0), cA + kstep, voffA); PG8_STAGE(PG8_SB(1, 1), cB + hstep + kstep, voffB);
        PG8_WAIT_V(6); PG8_BAR;
    }
    for (;;) {
        const bool has_next = S.next(ui + 1, nxt);
        const char* nA = has_next ? (const char*)g.A + (size_t)nxt.pm * tstep : cA; const char* nB = has_next ? (const char*)g.Bt + (size_t)nxt.pn * tstep : cB;
        for (int t = 0; t < nt; t += 2) {
            const bool last = (t == nt - 2);
            const char* a1 = cA + (size_t)(t + 1) * kstep;
            const char* a2 = last ? nA : cA + (size_t)(t + 2) * kstep; const char* b2 = last ? nB : cB + (size_t)(t + 2) * kstep;
            const char* a3 = a2 + kstep; const char* b3 = b2 + kstep;
            if (last && has_next) S.a_ready(nxt);
            if constexpr (SP2) {
            PG8_LDB(B0, 0, 0); PG8_LDB(B1, 0, 1); PG8_SCHED; PG8_LDA(At, 0, 0); PG8_STAGE(PG8_SA(1, 1), a1 + hstep, voffA);
            PG8_WAIT_V(8); PG8_WAIT_L(0); PG8_BAR; PG8_MMA(0, 0, At, B0); PG8_MMA(0, 1, At, B1); PG8_BAR; PG8_SCHED;
            PG8_LDA(At, 0, 1); PG8_STAGE(PG8_SB(0, 0), b2, voffB); PG8_STAGE(PG8_SB(0, 1), b2 + hstep, voffB); PG8_STAGE(PG8_SA(0, 0), a2, voffA);
            PG8_WAIT_V(8); PG8_WAIT_L(0); PG8_BAR; PG8_MMA(1, 0, At, B0); PG8_MMA(1, 1, At, B1); PG8_BAR; PG8_SCHED;
            PG8_LDB(B0, 1, 0); PG8_LDB(B1, 1, 1); PG8_SCHED; PG8_LDA(At, 1, 0); PG8_STAGE(PG8_SA(0, 1), a2 + hstep, voffA);
            PG8_WAIT_V(8); PG8_WAIT_L(0); PG8_BAR; PG8_MMA(0, 0, At, B0); PG8_MMA(0, 1, At, B1); PG8_BAR; PG8_SCHED;
            PG8_LDA(At, 1, 1); PG8_STAGE(PG8_SB(1, 0), b3, voffB); PG8_STAGE(PG8_SB(1, 1), b3 + hstep, voffB); PG8_STAGE(PG8_SA(1, 0), a3, voffA);
            PG8_WAIT_V(8); PG8_WAIT_L(0); PG8_BAR; PG8_MMA(1, 0, At, B0); PG8_MMA(1, 1, At, B1); PG8_BAR; PG8_SCHED;
            } else {
            PG8_LDB(B0, 0, 0); PG8_SCHED; PG8_LDA(At, 0, 0); PG8_STAGE(PG8_SA(1, 1), a1 + hstep, voffA);
            PG8_WAIT_L(8); PG8_BAR; PG8_WAIT_L(0); PG8_MMA(0, 0, At, B0); PG8_BAR; PG8_SCHED;
            PG8_LDB(B1, 0, 1); PG8_STAGE(PG8_SB(0, 0), b2, voffB);
            PG8_BAR; PG8_WAIT_L(0); PG8_MMA(0, 1, At, B1); PG8_BAR;
            PG8_LDA(At, 0, 1); PG8_STAGE(PG8_SA(0, 0), a2, voffA);
            PG8_BAR; PG8_WAIT_L(0); PG8_MMA(1, 0, At, B0); PG8_BAR; PG8_SCHED;
            PG8_STAGE(PG8_SB(0, 1), b2 + hstep, voffB);
            PG8_WAIT_V(6); PG8_BAR; PG8_MMA(1, 1, At, B1); PG8_BAR;
            PG8_LDB(B0, 1, 0); PG8_SCHED; PG8_LDA(At, 1, 0); PG8_STAGE(PG8_SA(0, 1), a2 + hstep, voffA);
            PG8_WAIT_L(8); PG8_BAR; PG8_WAIT_L(0); PG8_MMA(0, 0, At, B0); PG8_BAR; PG8_SCHED;
            PG8_LDB(B1, 1, 1); PG8_STAGE(PG8_SB(1, 0), b3, voffB);
            PG8_BAR; PG8_WAIT_L(0); PG8_MMA(0, 1, At, B1); PG8_BAR;
            PG8_LDA(At, 1, 1); PG8_STAGE(PG8_SA(1, 0), a3, voffA);
            PG8_BAR; PG8_WAIT_L(0); PG8_MMA(1, 0, At, B0); PG8_BAR; PG8_SCHED;
            PG8_STAGE(PG8_SB(1, 1), b3 + hstep, voffB);
            PG8_WAIT_V(6); PG8_BAR; PG8_MMA(1, 1, At, B1); PG8_BAR;
            }
        }
        if constexpr (ALIGN_EPI) { if (wr == 0) PG8_BAR; }
        if constexpr (Epi::HAS_PRE) {
            if (has_next) { const auto pn_ = E.pre_load(nxt.pm, tid); E(acc, cur, wr, wc, fr, fq, ptab + (ui & 1) * 256); E.pre_store(pn_, ptab + ((ui + 1) & 1) * 256, tid); }
            else E(acc, cur, wr, wc, fr, fq, ptab + (ui & 1) * 256);
        } else { E(acc, cur, wr, wc, fr, fq, ptab); }
        S.done(cur);
        if (!has_next) break;
#pragma unroll
        for (int a = 0; a < 2; ++a)
#pragma unroll
            for (int b = 0; b < 2; ++b)
#pragma unroll
                for (int m = 0; m < 4; ++m)
#pragma unroll
                    for (int n = 0; n < 2; ++n) acc[a][b][m][n] = (f32x4){0.f, 0.f, 0.f, 0.f};
        cur = nxt; cA = nA; cB = nB; ++ui;
        if constexpr (ALIGN_EPI) { if (wr == 1) PG8_BAR; }
    }
    PG8_WAIT_V(0);
    if constexpr (!ALIGN_EPI) { if (wr == 0) PG8_BAR; }
    PG8_BAR;
#undef PG8_SA
#undef PG8_SB
#undef PG8_STAGE
#undef PG8_LDA
#undef PG8_LDB
#undef PG8_MMA
#undef PG8_WAIT_V
#undef PG8_WAIT_L
#undef PG8_BAR
#undef PG8_SCHED
}
}

#ifndef PROBE
#define PROBE 0
#endif
constexpr int NB = 32, SEQ = 2048, DM = 1024, MTOK = NB * SEQ, INW = 3096, ZW = 3328, FF = 4096, DEPTH = 2;
constexpr int ZC_RQ = 0, ZC_RK = 256, ZC_RV = 512, ZC_RG = 768, ZC_CB = 1024, ZC_CC = 1280, ZC_CH = 1536, ZC_NQ = 1792,
              ZC_KC = 2304, ZC_VC = 2432, ZC_KS = 2560, ZC_VS = 2688, ZC_KW = 2816, ZC_VW = 2944, ZC_NG = 3072;
constexpr float EPS = 1e-6f, LOG2E = 1.4426950408889634f;
constexpr size_t MiB = 1u << 20;
constexpr size_t WS_WIN = 1 * MiB, WS_WOUT = 14 * MiB, WS_WUP = 18 * MiB, WS_WDN = 34 * MiB, WS_CS = 50 * MiB, WS_KCMP = 51 * MiB, WS_VCMP = 52 * MiB,
                 WS_KSN = 53 * MiB, WS_KWN = 69 * MiB, WS_SSQ = 86 * MiB, WS_W1T = 90 * MiB, WS_CB = 91 * MiB, WS_XN = 96 * MiB, WS_Z = 224 * MiB, WS_H = 224 * MiB, WS_MIX = 736 * MiB, WS_END = 896 * MiB;
constexpr int LDS_BYTES = 139264;
constexpr int NWAVES = 8, NTHREADS = 512;

struct KArgs { const float* in[16]; float* out; unsigned char* ws; int ph_lo, ph_hi; };
enum { I_X = 0, I_NORM_MIX, I_W_IN, I_CONV_W, I_QN, I_KN, I_PEK, I_W1K, I_W2K, I_PEV, I_W1V, I_W2V, I_W_OUT, I_NORM_MLP, I_W_UP, I_W_DOWN };

__device__ __forceinline__ float bf2f(unsigned short u) { return __uint_as_float((unsigned)u << 16); }
__device__ __forceinline__ unsigned f2bf(float f) { unsigned u = __float_as_uint(f); return (u + 0x7fffu + ((u >> 16) & 1u)) >> 16; }
__device__ __forceinline__ unsigned pk2(float lo, float hi) { return f2bf(lo) | (f2bf(hi) << 16); }
__device__ __forceinline__ float wave_sum(float v) {
#pragma unroll
    for (int o = 1; o < 64; o <<= 1) v += __shfl_xor(v, o);
    return v;
}
__device__ __forceinline__ float wave_max(float v) {
#pragma unroll
    for (int o = 1; o < 64; o <<= 1) v = fmaxf(v, __shfl_xor(v, o));
    return v;
}
#define LDS_FENCE() asm volatile("s_waitcnt lgkmcnt(0)" ::: "memory")

__device__ __forceinline__ void transpose_item(const float* W, int K, int N, int Npad, bf16_t* WT, LAS float* scr, int item, int lane, const float* gain) {
    const int nblk = Npad / 32, kb = item / nblk, nb = item % nblk, k0 = 64 * kb, n0 = 32 * nb;
    const int n = n0 + (lane & 31);
#pragma unroll 8
    for (int i = 0; i < 32; ++i) { const int kk = 2 * i + (lane >> 5); scr[kk * 33 + (lane & 31)] = (n < N) ? W[(size_t)(k0 + kk) * N + n] * (gain ? gain[k0 + kk] : 1.f) : 0.f; }
    LDS_FENCE();
    const int c = lane & 7;
#pragma unroll
    for (int j = 0; j < 4; ++j) { const int nn = (lane >> 3) + 8 * j; const LAS float* s = scr + (8 * c) * 33 + nn;
        u32x4 o; o.x = pk2(s[0 * 33], s[1 * 33]); o.y = pk2(s[2 * 33], s[3 * 33]); o.z = pk2(s[4 * 33], s[5 * 33]); o.w = pk2(s[6 * 33], s[7 * 33]);
        *(u32x4*)(WT + (size_t)(n0 + nn) * K + k0 + 8 * c) = o; }
    LDS_FENCE();
}

__device__ __forceinline__ void phase_prologue(const KArgs& a, LAS unsigned char* lds, int wave, int lane) {
    LAS float* scr = (LAS float*)(lds + wave * 16384);
    const int gw = blockIdx.x * NWAVES + wave, NGW = gridDim.x * NWAVES;
    constexpr int I_IN = (DM / 64) * (ZW / 32), I_OUT = (DM / 64) * (DM / 32), I_UP = (DM / 64) * (FF / 32), I_DN = (FF / 64) * (DM / 32);
    constexpr int PER_L = I_IN + I_OUT + I_UP + I_DN;
    for (int it = gw; it < DEPTH * PER_L; it += NGW) {
        const int l = it / PER_L; int r = it % PER_L;
        if (r < I_IN) { transpose_item(a.in[I_W_IN] + (size_t)l * DM * INW, DM, INW, ZW, (bf16_t*)(a.ws + WS_WIN) + (size_t)l * ZW * DM, scr, r, lane, a.in[I_NORM_MIX] + l * DM); continue; } r -= I_IN;
        if (r < I_OUT) { transpose_item(a.in[I_W_OUT] + (size_t)l * DM * DM, DM, DM, DM, (bf16_t*)(a.ws + WS_WOUT) + (size_t)l * DM * DM, scr, r, lane, nullptr); continue; } r -= I_OUT;
        if (r < I_UP) { transpose_item(a.in[I_W_UP] + (size_t)l * DM * FF, DM, FF, FF, (bf16_t*)(a.ws + WS_WUP) + (size_t)l * FF * DM, scr, r, lane, a.in[I_NORM_MLP] + l * DM); continue; } r -= I_UP;
        transpose_item(a.in[I_W_DOWN] + (size_t)l * FF * DM, FF, DM, DM, (bf16_t*)(a.ws + WS_WDN) + (size_t)l * DM * FF, scr, r, lane, nullptr);
    }
    for (int e = blockIdx.x * NTHREADS + threadIdx.x; e < DEPTH * 2 * 2048 * 8; e += gridDim.x * NTHREADS) {
        const int c8 = e & 7, ksrc = (e >> 3) & 2047, lk = e >> 14, l = lk >> 1, kv = lk & 1;
        const float* src = a.in[kv ? I_W1V : I_W1K] + ((size_t)l * 2048 + ksrc) * 64 + c8 * 8;
        const f32x4 v0 = *(const f32x4*)src, v1 = *(const f32x4*)(src + 4);
        const int lpos = ksrc >> 6, d = ksrc & 63, a2 = lpos >> 4, lp = lpos & 15;
        bf16_t* dst = (bf16_t*)(a.ws + WS_W1T) + ((size_t)lk * 128 + a2 * 64 + c8 * 8) * 1024 + lp * 64 + d;
#pragma unroll
        for (int i = 0; i < 4; ++i) { dst[(size_t)i * 1024] = (bf16_t)f2bf(v0[i]); dst[(size_t)(4 + i) * 1024] = (bf16_t)f2bf(v1[i]); }
    }
    if (blockIdx.x < 4) {
        const int lk = blockIdx.x, l = lk >> 1, kv = lk & 1, j = lane;
        const float* pe = a.in[kv ? I_PEV : I_PEK] + (size_t)l * 2048; const float* w1 = a.in[kv ? I_W1V : I_W1K] + (size_t)l * 2048 * 64;
        float s = 0.f;
        for (int k = wave * 256; k < wave * 256 + 256; ++k) s += pe[k] * w1[(size_t)k * 64 + j];
        LAS float* red = (LAS float*)(lds + 131072);
        red[wave * 64 + lane] = s;
        __syncthreads();
        if (wave == 0) { float t = 0.f;
#pragma unroll
            for (int w = 0; w < 8; ++w) t += red[w * 64 + lane];
            ((float*)(a.ws + WS_CB))[lk * 64 + j] = t; }
    }
    float2* cs = (float2*)(a.ws + WS_CS);
    for (int e = blockIdx.x * NTHREADS + threadIdx.x; e < SEQ * 32; e += gridDim.x * NTHREADS) {
        const int pos = e >> 5, i = e & 31;
        const float inv_freq = exp2f(-(float)i * 0.42863588321127255f);
        const float ang = (float)pos * inv_freq;
        const double rev = (double)ang * 0.15915494309189535;
        const float fr = (float)(rev - floor(rev));
        cs[e] = make_float2(__builtin_amdgcn_cosf(fr), __builtin_amdgcn_sinf(fr));
    }
}

__device__ __forceinline__ void phase_norm(const float* x, const float* gain, bf16_t* xn, float* rs, int wave, int lane) {
    const int gw = blockIdx.x * NWAVES + wave, NGW = gridDim.x * NWAVES;
    f32x4 gv[4];
#pragma unroll
    for (int j = 0; j < 4; ++j) gv[j] = *((const f32x4*)gain + 64 * j + lane);
    for (int m = gw; m < MTOK; m += NGW) {
        const f32x4* xr = (const f32x4*)(x + (size_t)m * DM) + lane;
        f32x4 v[4]; float s = 0.f;
#pragma unroll
        for (int j = 0; j < 4; ++j) { v[j] = xr[64 * j]; s += (v[j].x * v[j].x + v[j].y * v[j].y) + (v[j].z * v[j].z + v[j].w * v[j].w); }
        const float rstd = rsqrtf(wave_sum(s) * (1.f / DM) + EPS);
        float hm = 0.f;
#pragma unroll
        for (int j = 0; j < 4; ++j) { v[j] = v[j] * rstd * gv[j]; hm = fmaxf(hm, fmaxf(fmaxf(fabsf(v[j].x), fabsf(v[j].y)), fmaxf(fabsf(v[j].z), fabsf(v[j].w)))); }
        hm = wave_max(hm);
        const float sc = (hm > 0.f) ? bf2f((unsigned short)f2bf(hm)) / hm : 1.f;
        u32x2* o8 = (u32x2*)(xn + (size_t)m * DM) + lane;
#pragma unroll
        for (int j = 0; j < 4; ++j) { u32x2 w; w.x = pk2(v[j].x * sc, v[j].y * sc); w.y = pk2(v[j].z * sc, v[j].w * sc); o8[64 * j] = w; }
        if (lane == 0) rs[m] = 1.f / sc;
    }
}

__device__ __forceinline__ void phase_xcvt(const float* x, bf16_t* xb, float* ssq, int wave, int lane) {
    const int gw = blockIdx.x * NWAVES + wave, NGW = gridDim.x * NWAVES;
    for (int m = gw; m < MTOK; m += NGW) {
        const f32x4* xr = (const f32x4*)(x + (size_t)m * DM) + lane;
        f32x4 v[4]; float s = 0.f;
#pragma unroll
        for (int j = 0; j < 4; ++j) { v[j] = xr[64 * j]; s += (v[j].x * v[j].x + v[j].y * v[j].y) + (v[j].z * v[j].z + v[j].w * v[j].w); }
        s = wave_sum(s);
        u32x2* o8 = (u32x2*)(xb + (size_t)m * DM) + lane;
#pragma unroll
        for (int j = 0; j < 4; ++j) { u32x2 w; w.x = pk2(v[j].x, v[j].y); w.y = pk2(v[j].z, v[j].w); o8[64 * j] = w; }
        if (lane < 16) ssq[(size_t)m * 16 + lane] = (lane == 0) ? s : 0.f;
    }
}

__device__ __forceinline__ void ret_item(const KArgs& a, int l, int bh, LAS unsigned char* lds, int wave, int lane) {
    int tid = threadIdx.x; asm volatile("" : "+v"(tid));
    const int b = bh >> 2, h = bh & 3;
    const float gamma = 1.0f - exp2f(-5.0f - (float)h);
    const bf16_t* Z = (const bf16_t*)(a.ws + WS_Z);
    bf16_t* MIX = (bf16_t*)(a.ws + WS_MIX);
    const float2* cs = (const float2*)(a.ws + WS_CS);
    LAS float* qs = (LAS float*)lds; LAS float* ks = qs + 32 * 64; LAS float* vs = ks + 32 * 64; LAS float* op = vs + 32 * 64;
    float S[8];
#pragma unroll
    for (int i = 0; i < 8; ++i) S[i] = 0.f;
    for (int tb = 0; tb < SEQ / 32; ++tb) {
#pragma unroll
        for (int r = 0; r < 2; ++r) {
            const int p = tid + r * NTHREADS, tt = p >> 5, i = p & 31, pos = tb * 32 + tt;
            const bf16_t* zr = Z + (size_t)(b * SEQ + pos) * ZW + h * 64 + 2 * i;
            const unsigned qq = *(const unsigned*)(zr + ZC_RQ), kk = *(const unsigned*)(zr + ZC_RK), vv = *(const unsigned*)(zr + ZC_RV);
            const float2 c = cs[pos * 32 + i];
            const float q0 = bf2f(qq & 0xffff), q1 = bf2f(qq >> 16), k0 = bf2f(kk & 0xffff), k1 = bf2f(kk >> 16);
            qs[tt * 64 + 2 * i] = q0 * c.x - q1 * c.y; qs[tt * 64 + 2 * i + 1] = q1 * c.x + q0 * c.y;
            ks[tt * 64 + 2 * i] = (k0 * c.x - k1 * c.y) * 0.125f; ks[tt * 64 + 2 * i + 1] = (k1 * c.x + k0 * c.y) * 0.125f;
            vs[tt * 64 + 2 * i] = bf2f(vv & 0xffff); vs[tt * 64 + 2 * i + 1] = bf2f(vv >> 16);
        }
        __syncthreads();
        for (int tt = 0; tt < 32; ++tt) {
            const f32x4 ka = *(const LAS f32x4*)(ks + tt * 64 + wave * 8), kb = *(const LAS f32x4*)(ks + tt * 64 + wave * 8 + 4);
            const f32x4 qa = *(const LAS f32x4*)(qs + tt * 64 + wave * 8), qb = *(const LAS f32x4*)(qs + tt * 64 + wave * 8 + 4);
            const float v = vs[tt * 64 + lane];
            float po = 0.f;
#pragma unroll
            for (int i = 0; i < 4; ++i) { S[i] = gamma * S[i] + ka[i] * v; po += qa[i] * S[i]; S[4 + i] = gamma * S[4 + i] + kb[i] * v; po += qb[i] * S[4 + i]; }
            op[(tt * 8 + wave) * 64 + lane] = po;
        }
        __syncthreads();
#pragma unroll
        for (int r = 0; r < 4; ++r) {
            const int tt = wave + 8 * r, pos = tb * 32 + tt;
            float o = 0.f;
#pragma unroll
            for (int w = 0; w < 8; ++w) o += op[(tt * 8 + w) * 64 + lane];
            const float rstd = rsqrtf(wave_sum(o * o) * (1.f / 64.f) + EPS);
            const size_t row = (size_t)(b * SEQ + pos);
            const float g = bf2f(Z[row * ZW + ZC_RG + h * 64 + lane]);
            const float sg = g / (1.f + __expf(-g));
            MIX[row * DM + h * 64 + lane] = (bf16_t)f2bf(sg * o * rstd);
        }
        __syncthreads();
    }
}

__device__ __forceinline__ void conv_item(const KArgs& a, int l, int item) {
    const bf16_t* Z = (const bf16_t*)(a.ws + WS_Z);
    bf16_t* MIX = (bf16_t*)(a.ws + WS_MIX);
    const float* cw = a.in[I_CONV_W] + (size_t)l * 3 * 256;
    int tid = threadIdx.x; asm volatile("" : "+v"(tid));
    const int cg8 = (tid & 31) * 8;
    float w0[8], w1[8], w2[8];
#pragma unroll
    for (int i = 0; i < 8; ++i) { w0[i] = cw[cg8 + i]; w1[i] = cw[256 + cg8 + i]; w2[i] = cw[512 + cg8 + i]; }
    const int rbase = item * 256 + (tid >> 5) * 16;
    for (int q = 0; q < 4; ++q) {
        const int r0 = rbase + 4 * q, s0 = r0 & (SEQ - 1);
        u32x4 cc[6], hh[6], bb[4];
#pragma unroll
        for (int i = 0; i < 6; ++i) { const int rr = (s0 == 0 && i < 2) ? r0 : r0 - 2 + i; const bf16_t* zr = Z + (size_t)rr * ZW + cg8; cc[i] = *(const u32x4*)(zr + ZC_CC); hh[i] = *(const u32x4*)(zr + ZC_CH); }
#pragma unroll
        for (int i = 0; i < 4; ++i) bb[i] = *(const u32x4*)(Z + (size_t)(r0 + i) * ZW + ZC_CB + cg8);
        float u[6][8];
#pragma unroll
        for (int i = 0; i < 6; ++i) { const float z = (s0 == 0 && i < 2) ? 0.f : 1.f;
#pragma unroll
            for (int j = 0; j < 4; ++j) { u[i][2 * j] = z * bf2f(cc[i][j] & 0xffff) * bf2f(hh[i][j] & 0xffff); u[i][2 * j + 1] = z * bf2f(cc[i][j] >> 16) * bf2f(hh[i][j] >> 16); } }
#pragma unroll
        for (int i = 0; i < 4; ++i) { u32x4 o;
#pragma unroll
            for (int j = 0; j < 4; ++j) {
                const float y0 = w0[2 * j] * u[i][2 * j] + w1[2 * j] * u[i + 1][2 * j] + w2[2 * j] * u[i + 2][2 * j];
                const float y1 = w0[2 * j + 1] * u[i][2 * j + 1] + w1[2 * j + 1] * u[i + 1][2 * j + 1] + w2[2 * j + 1] * u[i + 2][2 * j + 1];
                o[j] = pk2(bf2f(bb[i][j] & 0xffff) * y0, bf2f(bb[i][j] >> 16) * y1); }
            *(u32x4*)(MIX + (size_t)(r0 + i) * DM + 256 + cg8) = o; }
    }
}

__device__ __forceinline__ void knorm_item(const KArgs& a, int l, int item, int wave, int lane) {
    const bf16_t* Z = (const bf16_t*)(a.ws + WS_Z);
    const float kg = a.in[I_KN][l * 64 + lane];
    for (int r0 = 0; r0 < 128; r0 += 16) {
        float v[16];
#pragma unroll
        for (int i = 0; i < 16; ++i) { const int task = item * 1024 + wave * 128 + r0 + i, row = task >> 2, which = (task >> 1) & 1, g = task & 1;
            v[i] = bf2f(Z[(size_t)row * ZW + (which ? ZC_KW : ZC_KS) + g * 64 + lane]); }
#pragma unroll
        for (int i = 0; i < 16; ++i) { const int task = item * 1024 + wave * 128 + r0 + i, row = task >> 2, which = (task >> 1) & 1, g = task & 1;
            const float rstd = rsqrtf(wave_sum(v[i] * v[i]) * (1.f / 64.f) + EPS);
            bf16_t* dst = (bf16_t*)(a.ws + (which ? WS_KWN : WS_KSN));
            dst[(size_t)row * 128 + g * 64 + lane] = (bf16_t)f2bf(v[i] * rstd * kg); }
    }
}

__device__ __forceinline__ void cmp_item(const KArgs& a, int l, int item, LAS unsigned char* lds, int wave, int lane) {
    int tid = threadIdx.x; asm volatile("" : "+v"(tid));
    const int nc = item & 7, kv = (item >> 3) & 1, g = (item >> 4) & 1, b = item >> 5;
    const bf16_t* Z = (const bf16_t*)(a.ws + WS_Z);
    const float* pe = a.in[kv ? I_PEV : I_PEK] + (size_t)l * 2048;
    const float* w1 = a.in[kv ? I_W1V : I_W1K] + (size_t)l * 2048 * 64;
    const float* w2 = a.in[kv ? I_W2V : I_W2K] + (size_t)l * 64 * 64;
    LAS float* xs = (LAS float*)lds;
    LAS float* red = xs + 272 * 64;
    LAS float* o1 = red + 8 * 16 * 64;
    const int t0 = nc * 256, zc = (kv ? ZC_VC : ZC_KC) + g * 64;
    for (int e = tid; e < 272 * 8; e += NTHREADS) {
        const int tt = e >> 3, c8 = (e & 7) * 8, tok = t0 + tt;
        u32x4 v = (u32x4){0u, 0u, 0u, 0u};
        if (tok < SEQ) v = *(const u32x4*)(Z + (size_t)(b * SEQ + tok) * ZW + zc + c8);
#pragma unroll
        for (int i = 0; i < 4; ++i) { xs[tt * 64 + c8 + 2 * i] = bf2f(v[i] & 0xffff); xs[tt * 64 + c8 + 2 * i + 1] = bf2f(v[i] >> 16); }
    }
    __syncthreads();
    float acc[16]; float accb = 0.f;
#pragma unroll
    for (int i = 0; i < 16; ++i) acc[i] = 0.f;
    for (int kk = 0; kk < 256; ++kk) {
        const int k = wave * 256 + kk, lpos = k >> 6, d = k & 63;
        const float w = w1[(size_t)k * 64 + lane];
        accb += pe[k] * w;
#pragma unroll
        for (int nb = 0; nb < 16; ++nb) acc[nb] += xs[(16 * nb + lpos) * 64 + d] * w;
    }
#pragma unroll
    for (int nb = 0; nb < 16; ++nb) red[(wave * 16 + nb) * 64 + lane] = acc[nb] + accb;
    __syncthreads();
    for (int e = tid; e < 16 * 64; e += NTHREADS) {
        float s = 0.f;
#pragma unroll
        for (int w = 0; w < 8; ++w) s += red[w * 16 * 64 + e];
        o1[e] = s / (1.f + __expf(-s));
    }
    __syncthreads();
    const float kg = a.in[I_KN][l * 64 + lane];
    bf16_t* dst = (bf16_t*)(a.ws + (kv ? WS_VCMP : WS_KCMP)) + (size_t)((b * 2 + g) * 128) * 64;
#pragma unroll
    for (int r = 0; r < 2; ++r) {
        const int nb = wave + 8 * r, n = nc * 16 + nb;
        float s = 0.f;
        for (int j = 0; j < 64; ++j) s += o1[nb * 64 + j] * w2[j * 64 + lane];
        if (!kv) { const float rstd = rsqrtf(wave_sum(s * s) * (1.f / 64.f) + EPS); s = s * rstd * kg; }
        if (n >= 127) s = 0.f;
        dst[(size_t)n * 64 + lane] = (bf16_t)f2bf(s);
    }
    __syncthreads();
}

__device__ __forceinline__ f32x4 dot4(const bf16_t* krow, const LAS float* qs) {
    float a0 = 0.f, a1 = 0.f, a2 = 0.f, a3 = 0.f;
#pragma unroll 1
    for (int c = 0; c < 8; ++c) {
        const u32x4 kv = *(const u32x4*)(krow + c * 8);
        float k[8];
#pragma unroll
        for (int i = 0; i < 4; ++i) { k[2 * i] = bf2f(kv[i] & 0xffff); k[2 * i + 1] = bf2f(kv[i] >> 16); }
#pragma unroll
        for (int h = 0; h < 4; ++h) {
            const f32x4 q0 = *(const LAS f32x4*)(qs + h * 64 + c * 8), q1 = *(const LAS f32x4*)(qs + h * 64 + c * 8 + 4);
            const float s = k[0] * q0[0] + k[1] * q0[1] + k[2] * q0[2] + k[3] * q0[3] + k[4] * q1[0] + k[5] * q1[1] + k[6] * q1[2] + k[7] * q1[3];
            if (h == 0) a0 += s; else if (h == 1) a1 += s; else if (h == 2) a2 += s; else a3 += s;
        }
    }
    return (f32x4){a0, a1, a2, a3};
}
__device__ __forceinline__ void blk_step(const f32x4 s, bool valid, const bf16_t* vbase, size_t vstride, int nk, LAS f32x4* pbuf, int lane, f32x4& m, f32x4& ls, f32x4& o) {
    f32x4 p;
#pragma unroll
    for (int h = 0; h < 4; ++h) {
        const float sm = valid ? s[h] : -1e30f;
        const float mn = fmaxf(m[h], wave_max(sm));
        const float sc = exp2f(m[h] - mn);
        p[h] = valid ? exp2f(s[h] - mn) : 0.f;
        ls[h] = ls[h] * sc + p[h]; o[h] *= sc; m[h] = mn;
    }
    LDS_FENCE();
    pbuf[lane] = p;
    LDS_FENCE();
    for (int key = 0; key < nk; ++key) {
        const f32x4 pp = pbuf[key];
        const float v = bf2f(vbase[(size_t)key * vstride + lane]);
        o[0] += pp[0] * v; o[1] += pp[1] * v; o[2] += pp[2] * v; o[3] += pp[3] * v;
    }
    LDS_FENCE();
}

__device__ __forceinline__ void nsa_task(const KArgs& a, int l, int b, int g, int t, LAS float* qs, LAS f32x4* pbuf, int lane_in) {
    int lane = lane_in; asm volatile("" : "+v"(lane));
    const bf16_t* Z = (const bf16_t*)(a.ws + WS_Z);
    const size_t row = (size_t)b * SEQ + t;
    const bf16_t* zrow = Z + row * ZW;
    {
        const int h = lane >> 4, dq = (lane & 15) * 4;
        const u32x2 qq = *(const u32x2*)(zrow + ZC_NQ + g * 256 + h * 64 + dq);
        float q0 = bf2f(qq.x & 0xffff), q1 = bf2f(qq.x >> 16), q2 = bf2f(qq.y & 0xffff), q3 = bf2f(qq.y >> 16);
        float ss = q0 * q0 + q1 * q1 + q2 * q2 + q3 * q3;
        ss += __shfl_xor(ss, 1); ss += __shfl_xor(ss, 2); ss += __shfl_xor(ss, 4); ss += __shfl_xor(ss, 8);
        const float rs = rsqrtf(ss * (1.f / 64.f) + EPS) * (0.125f * LOG2E);
        const f32x4 gq = *(const f32x4*)(a.in[I_QN] + l * 64 + dq);
        LDS_FENCE();
        *(LAS f32x4*)(qs + h * 64 + dq) = (f32x4){q0 * rs * gq[0], q1 * rs * gq[1], q2 * rs * gq[2], q3 * rs * gq[3]};
        LDS_FENCE();
    }
    const int nvis = (t >= 31) ? (((t - 31) >> 4) + 1) : 0;
    const bf16_t* kc = (const bf16_t*)(a.ws + WS_KCMP) + (size_t)((b * 2 + g) * 128) * 64;
    const bf16_t* vc = (const bf16_t*)(a.ws + WS_VCMP) + (size_t)((b * 2 + g) * 128) * 64;
    f32x4 ocmp = (f32x4){0.f, 0.f, 0.f, 0.f};
    float imp = 0.f;
    {
        const bool v1 = lane < nvis, v2 = lane + 64 < nvis;
        const f32x4 s1 = dot4(kc + (size_t)lane * 64, qs), s2 = dot4(kc + (size_t)(lane + 64) * 64, qs);
        f32x4 p1, p2;
#pragma unroll
        for (int h = 0; h < 4; ++h) {
            const float m = wave_max(fmaxf(v1 ? s1[h] : -1e30f, v2 ? s2[h] : -1e30f));
            p1[h] = v1 ? exp2f(s1[h] - m) : 0.f; p2[h] = v2 ? exp2f(s2[h] - m) : 0.f;
            const float inv = 1.f / fmaxf(wave_sum(p1[h] + p2[h]), 1e-30f);
            p1[h] *= inv; p2[h] *= inv;
        }
        LDS_FENCE();
        pbuf[lane] = p1; pbuf[lane + 64] = p2;
        LDS_FENCE();
        {
            const int j = lane & 31;
            const f32x4 pa = pbuf[4 * j], pb = pbuf[4 * j + 1], pc = pbuf[4 * j + 2], pd = pbuf[4 * j + 3];
            f32x4 pe = (f32x4){0.f, 0.f, 0.f, 0.f}; if (j > 0) pe = pbuf[4 * j - 1];
#pragma unroll
            for (int h = 0; h < 4; ++h) imp += pa[h] + pb[h] + pc[h] + 0.5f * pd[h] + 0.5f * pe[h];
        }
        for (int n = 0; n < nvis; ++n) {
            const f32x4 pp = pbuf[n];
            const float v = bf2f(vc[(size_t)n * 64 + lane]);
            ocmp[0] += pp[0] * v; ocmp[1] += pp[1] * v; ocmp[2] += pp[2] * v; ocmp[3] += pp[3] * v;
        }
        LDS_FENCE();
    }
    const int tb = t >> 6;
    unsigned mask;
    {
        const int j = lane & 31;
        const bool elig = j <= tb, forced = (j == 0) || (j == tb) || (j == tb - 1);
        const float sc = elig ? (imp + (forced ? 1e4f : 0.f)) : -1.0f;
        int rank = 0;
#pragma unroll
        for (int jj = 0; jj < 32; ++jj) { const float o = __uint_as_float(__builtin_amdgcn_readlane(__float_as_uint(sc), jj)); rank += (o > sc || (o == sc && jj < j)) ? 1 : 0; }
        mask = (unsigned)(__ballot(rank < 8 && lane < 32) & 0xffffffffull);
    }
    f32x4 ms = (f32x4){-1e30f, -1e30f, -1e30f, -1e30f}, lsl = (f32x4){0.f, 0.f, 0.f, 0.f}, os = (f32x4){0.f, 0.f, 0.f, 0.f};
    const bf16_t* ksn = (const bf16_t*)(a.ws + WS_KSN) + (size_t)b * SEQ * 128 + g * 64;
    for (int j = 0; j <= tb; ++j) {
        if (!((mask >> j) & 1u)) continue;
        const int key = 64 * j + lane; const bool valid = key <= t;
        const f32x4 s = dot4(ksn + (size_t)key * 128, qs);
        const int nk = min(64, t - 64 * j + 1);
        blk_step(s, valid, Z + ((size_t)b * SEQ + 64 * j) * ZW + ZC_VS + g * 64, ZW, nk, pbuf, lane, ms, lsl, os);
    }
    f32x4 mw = (f32x4){-1e30f, -1e30f, -1e30f, -1e30f}, lw = (f32x4){0.f, 0.f, 0.f, 0.f}, ow = (f32x4){0.f, 0.f, 0.f, 0.f};
    const bf16_t* kwn = (const bf16_t*)(a.ws + WS_KWN) + (size_t)b * SEQ * 128 + g * 64;
    for (int j = max(0, tb - 4); j <= tb; ++j) {
        const int key = 64 * j + lane; const bool valid = (key <= t) && (key > t - 256);
        const f32x4 s = dot4(kwn + (size_t)key * 128, qs);
        const int nk = min(64, t - 64 * j + 1);
        blk_step(s, valid, Z + ((size_t)b * SEQ + 64 * j) * ZW + ZC_VW + g * 64, ZW, nk, pbuf, lane, mw, lw, ow);
    }
    bf16_t* MIX = (bf16_t*)(a.ws + WS_MIX);
#pragma unroll
    for (int h = 0; h < 4; ++h) {
        const float l1 = wave_sum(lsl[h]), l2 = wave_sum(lw[h]);
        const bf16_t* gp = zrow + ZC_NG + (g * 4 + h) * 3;
        const float g0 = 1.f / (1.f + __expf(-bf2f(gp[0]))), g1 = 1.f / (1.f + __expf(-bf2f(gp[1]))), g2 = 1.f / (1.f + __expf(-bf2f(gp[2])));
        const float o = g0 * ocmp[h] + g1 * os[h] / fmaxf(l1, 1e-30f) + g2 * ow[h] / fmaxf(l2, 1e-30f);
        MIX[row * DM + 512 + (g * 4 + h) * 64 + lane] = (bf16_t)f2bf(o);
    }
}

__device__ __forceinline__ void phase_nsa(const KArgs& a, int l, LAS unsigned char* lds, int wave, int lane) {
    LAS float* qs = (LAS float*)(lds + wave * 4096);
    LAS f32x4* pbuf = (LAS f32x4*)(lds + wave * 4096 + 1024);
    const int gw = blockIdx.x * NWAVES + wave, NGW = gridDim.x * NWAVES;
    for (int task = gw; task < NB * 2 * SEQ; task += NGW) {
        const int bg = task >> 11, t = task & (SEQ - 1);
        nsa_task(a, l, bg >> 1, bg & 1, t, qs, pbuf, lane);
    }
}

typedef float f32x16 __attribute__((ext_vector_type(16)));
typedef short s16x4 __attribute__((ext_vector_type(4)));
constexpr int KST = 144, VST = 192;
constexpr int L_KC = 0, L_VC = 18432, L_KT = 43008, L_VT = 61440, L_IMP = 86016, L_SEL = 102400, L_UNI = 102656;
__device__ __forceinline__ int crow(int r, int hi) { return (r & 3) + 8 * (r >> 2) + 4 * hi; }
__device__ __forceinline__ s16x4 tr_read(const LAS unsigned char* p) { return __builtin_bit_cast(s16x4, __builtin_amdgcn_ds_read_tr16_b64_v4i16((LAS s16x4*)p)); }
__device__ __forceinline__ bf16x8 pack8(const f32x16& P, int base) {
    u32x4 w; w.x = pg8::cvt_pk_bf16(P[base + 0], P[base + 1]); w.y = pg8::cvt_pk_bf16(P[base + 2], P[base + 3]); w.z = pg8::cvt_pk_bf16(P[base + 4], P[base + 5]); w.w = pg8::cvt_pk_bf16(P[base + 6], P[base + 7]);
    return __builtin_bit_cast(bf16x8, w);
}
__device__ __forceinline__ void pv_step(f32x16 (&o)[2], const LAS unsigned char* vt, int s, bf16x8 bfrag, int lane) {
    const int i = lane & 15, hi = lane >> 5, dh = (lane >> 4) & 1;
    const LAS unsigned char* p = vt + (16 * s + 4 * hi + (i >> 2)) * VST + (16 * dh + 4 * (i & 3)) * 2;
#pragma unroll
    for (int dt = 0; dt < 2; ++dt) {
        const s16x4 lo = tr_read(p + dt * 64), hh = tr_read(p + dt * 64 + 8 * VST);
        const bf16x8 af = (bf16x8){lo[0], lo[1], lo[2], lo[3], hh[0], hh[1], hh[2], hh[3]};
        o[dt] = __builtin_amdgcn_mfma_f32_32x32x16_bf16(af, bfrag, o[dt], 0, 0, 0);
    }
}
__device__ __forceinline__ void nsa_mfma_item(const KArgs& a, int l, int b, int g, int tq, LAS unsigned char* lds, int wave, int lane_in, float shiftc) {
    int lane = lane_in; asm volatile("" : "+v"(lane));
    const int tid = wave * 64 + lane;
    const bf16_t* Z = (const bf16_t*)(a.ws + WS_Z);
    const int t0 = tq * 64, tb = tq; const size_t rowbase = (size_t)b * SEQ;
    const int c = lane & 31, hi = lane >> 5, tl = c >> 2, h = c & 3;
    const int tok = 8 * wave + tl, t = t0 + tok;
    __syncthreads();
    {
        const bf16_t* kc = (const bf16_t*)(a.ws + WS_KCMP) + (size_t)((b * 2 + g) * 128) * 64;
        const bf16_t* vc = (const bf16_t*)(a.ws + WS_VCMP) + (size_t)((b * 2 + g) * 128) * 64;
#pragma unroll
        for (int r = 0; r < 2; ++r) { const int e = tid + r * NTHREADS, key = e >> 3, ch = e & 7;
            const u32x4 kk = *(const u32x4*)(kc + key * 64 + ch * 8), vv = *(const u32x4*)(vc + key * 64 + ch * 8);
            *(LAS u32x4*)(lds + L_KC + key * KST + ch * 16) = kk; *(LAS u32x4*)(lds + L_VC + key * VST + ch * 16) = vv; }
    }
    const int skey = tid >> 3, sch = tid & 7;
    u32x4 kregA, vregA, kregB = (u32x4){0u, 0u, 0u, 0u}, vregB = (u32x4){0u, 0u, 0u, 0u};
    const bf16_t* ksn = (const bf16_t*)(a.ws + WS_KSN); const bf16_t* kwn = (const bf16_t*)(a.ws + WS_KWN);
#define NSA_LOAD_TILE(idx, KR, VR) do { const int ty_ = (idx) >> 5, j_ = (idx) & 31; const size_t row_ = rowbase + 64 * j_ + skey; \
        KR = *(const u32x4*)((ty_ ? kwn : ksn) + row_ * 128 + g * 64 + sch * 8); \
        VR = *(const u32x4*)(Z + row_ * ZW + (ty_ ? ZC_VW : ZC_VS) + g * 64 + sch * 8); } while (0)
    NSA_LOAD_TILE(0, kregA, vregA);
    const bf16_t* zrow = Z + (rowbase + t) * ZW;
    bf16x8 qf[4];
    {
        u32x4 raw[4]; float ss = 0.f;
#pragma unroll
        for (int ks = 0; ks < 4; ++ks) { raw[ks] = *(const u32x4*)(zrow + ZC_NQ + g * 256 + h * 64 + 16 * ks + 8 * hi);
#pragma unroll
            for (int i = 0; i < 4; ++i) { const float x0 = bf2f(raw[ks][i] & 0xffff), x1 = bf2f(raw[ks][i] >> 16); ss += x0 * x0 + x1 * x1; } }
        ss += __shfl_xor(ss, 32);
        const float rs = rsqrtf(ss * (1.f / 64.f) + EPS) * (0.125f * LOG2E);
#pragma unroll
        for (int ks = 0; ks < 4; ++ks) { const float* gp = a.in[I_QN] + l * 64 + 16 * ks + 8 * hi; const f32x4 ga = *(const f32x4*)gp, gb = *(const f32x4*)(gp + 4);
            u32x4 w;
            w.x = pg8::cvt_pk_bf16(bf2f(raw[ks][0] & 0xffff) * rs * ga[0], bf2f(raw[ks][0] >> 16) * rs * ga[1]);
            w.y = pg8::cvt_pk_bf16(bf2f(raw[ks][1] & 0xffff) * rs * ga[2], bf2f(raw[ks][1] >> 16) * rs * ga[3]);
            w.z = pg8::cvt_pk_bf16(bf2f(raw[ks][2] & 0xffff) * rs * gb[0], bf2f(raw[ks][2] >> 16) * rs * gb[1]);
            w.w = pg8::cvt_pk_bf16(bf2f(raw[ks][3] & 0xffff) * rs * gb[2], bf2f(raw[ks][3] >> 16) * rs * gb[3]);
            qf[ks] = __builtin_bit_cast(bf16x8, w); }
    }
    float g0, g1, g2;
    { const bf16_t* gp = zrow + ZC_NG + (g * 4 + h) * 3; g0 = 1.f / (1.f + __expf(-bf2f(gp[0]))); g1 = 1.f / (1.f + __expf(-bf2f(gp[1]))); g2 = 1.f / (1.f + __expf(-bf2f(gp[2]))); }
    __syncthreads();
    f32x16 otot[2];
    unsigned mymask;
    {
        f32x16 pc[4];
#pragma unroll
        for (int kt = 0; kt < 4; ++kt) { pc[kt] = (f32x16){};
#pragma unroll
            for (int ks = 0; ks < 4; ++ks) { const bf16x8 kf = *(const LAS bf16x8*)(lds + L_KC + (32 * kt + c) * KST + (16 * ks + 8 * hi) * 2);
                pc[kt] = __builtin_amdgcn_mfma_f32_32x32x16_bf16(kf, qf[ks], pc[kt], 0, 0, 0); } }
        const int nvis = (t >= 31) ? (((t - 31) >> 4) + 1) : 0;
        float mx = -1e30f;
#pragma unroll
        for (int kt = 0; kt < 4; ++kt)
#pragma unroll
            for (int r = 0; r < 16; ++r) { const int n = 32 * kt + crow(r, hi); const float sv = (n < nvis) ? pc[kt][r] : -INFINITY; pc[kt][r] = sv; mx = fmaxf(mx, sv); }
        mx = fmaxf(mx, __shfl_xor(mx, 32));
        float sum = 0.f;
#pragma unroll
        for (int kt = 0; kt < 4; ++kt)
#pragma unroll
            for (int r = 0; r < 16; ++r) { const float p = __builtin_amdgcn_exp2f(pc[kt][r] - mx); pc[kt][r] = p; sum += p; }
        sum += __shfl_xor(sum, 32);
        const float inv = 1.f / fmaxf(sum, 1e-30f);
#pragma unroll
        for (int kt = 0; kt < 4; ++kt)
#pragma unroll
            for (int r = 0; r < 16; ++r) pc[kt][r] *= inv;
        LAS float* impA = (LAS float*)(lds + L_IMP + wave * 2048); LAS float* impC = impA + 256;
#pragma unroll
        for (int kt = 0; kt < 4; ++kt)
#pragma unroll
            for (int gq = 0; gq < 4; ++gq) {
                float A = pc[kt][4 * gq] + pc[kt][4 * gq + 1] + pc[kt][4 * gq + 2] + 0.5f * pc[kt][4 * gq + 3], C = 0.5f * pc[kt][4 * gq + 3];
                A += __shfl_xor(A, 1); A += __shfl_xor(A, 2); C += __shfl_xor(C, 1); C += __shfl_xor(C, 2);
                const int j = 8 * kt + 2 * gq + hi;
                if (h == 0) { impA[tl * 32 + j] = A; if (j < 31) impC[tl * 32 + j + 1] = C; }
            }
        if (h == 0 && hi == 0) impC[tl * 32] = 0.f;
        f32x16 oc[2]; oc[0] = (f32x16){}; oc[1] = (f32x16){};
#pragma unroll
        for (int s8 = 0; s8 < 8; ++s8) pv_step(oc, lds + L_VC, s8, pack8(pc[s8 >> 1], 8 * (s8 & 1)), lane);
#pragma unroll
        for (int dt = 0; dt < 2; ++dt)
#pragma unroll
            for (int r = 0; r < 16; ++r) otot[dt][r] = g0 * oc[dt][r];
        LDS_FENCE();
        const int tk = lane >> 3, jg = lane & 7;
        const LAS float* ia = impA + tk * 32; const LAS float* ic = impC + tk * 32;
        float sc[32];
#pragma unroll
        for (int q4 = 0; q4 < 8; ++q4) { const f32x4 x = *(const LAS f32x4*)(ia + 4 * q4) + *(const LAS f32x4*)(ic + 4 * q4);
#pragma unroll
            for (int u = 0; u < 4; ++u) { const int j = 4 * q4 + u; const bool forced = (j == 0) || (j == tb) || (j == tb - 1); sc[j] = (j <= tb) ? (x[u] + (forced ? 1e4f : 0.f)) : -1.0f; } }
        float so[4];
        { const f32x4 x = *(const LAS f32x4*)(ia + 4 * jg) + *(const LAS f32x4*)(ic + 4 * jg);
#pragma unroll
            for (int u = 0; u < 4; ++u) { const int j = 4 * jg + u; const bool forced = (j == 0) || (j == tb) || (j == tb - 1); so[u] = (j <= tb) ? (x[u] + (forced ? 1e4f : 0.f)) : -1.0f; } }
        unsigned part = 0u;
#pragma unroll
        for (int u = 0; u < 4; ++u) { const int j = 4 * jg + u; int rank = 0;
#pragma unroll
            for (int jj = 0; jj < 32; ++jj) rank += (sc[jj] > so[u] || (sc[jj] == so[u] && jj < j)) ? 1 : 0;
            part |= (rank < 8 ? 1u : 0u) << j; }
        part |= __shfl_xor(part, 1); part |= __shfl_xor(part, 2); part |= __shfl_xor(part, 4);
        LAS unsigned* selm = (LAS unsigned*)(lds + L_SEL);
        if (jg == 0) selm[wave * 8 + tk] = part;
        unsigned uni = part; uni |= __shfl_xor(uni, 8); uni |= __shfl_xor(uni, 16); uni |= __shfl_xor(uni, 32);
        if (lane == 0) ((LAS unsigned*)(lds + L_UNI))[wave] = uni;
        LDS_FENCE();
        mymask = selm[wave * 8 + tl];
    }
    __syncthreads();
    unsigned uniall = 0u;
    { const LAS unsigned* up = (const LAS unsigned*)(lds + L_UNI);
#pragma unroll
        for (int w = 0; w < 8; ++w) uniall |= up[w]; }
    uniall = __builtin_amdgcn_readfirstlane(uniall);
    const unsigned upto = (2u << tb) - 1u;
    const int wlo = tb - 4 > 0 ? tb - 4 : 0;
    unsigned long long list = (unsigned long long)(uniall & upto) | ((unsigned long long)(upto & ~((1u << wlo) - 1u)) << 32);
    float lsum = 0.f; f32x16 o[2]; o[0] = (f32x16){}; o[1] = (f32x16){};
    int curA = 0, curB = -1; list &= list - 1ull;
    int buf = 0, prevtype = 0;
    while (curA >= 0) {
        LAS unsigned char* sb = lds + buf * 43008;
        *(LAS u32x4*)(sb + skey * KST + sch * 16) = kregA; *(LAS u32x4*)(sb + 18432 + skey * VST + sch * 16) = vregA;
        if (curB >= 0) { *(LAS u32x4*)(sb + (64 + skey) * KST + sch * 16) = kregB; *(LAS u32x4*)(sb + 18432 + (64 + skey) * VST + sch * 16) = vregB; }
        __syncthreads();
        int nxtA = -1, nxtB = -1;
        if (list) { nxtA = __builtin_ctzll(list); list &= list - 1ull; NSA_LOAD_TILE(nxtA, kregA, vregA);
            if (list) { const int nb_ = __builtin_ctzll(list); if ((nb_ >> 5) == (nxtA >> 5)) { nxtB = nb_; list &= list - 1ull; NSA_LOAD_TILE(nxtB, kregB, vregB); } } }
        const int type = curA >> 5, jA = curA & 31, jB = curB & 31; const bool hasB = curB >= 0;
        if (type != prevtype) {
            const float lt = lsum + __shfl_xor(lsum, 32); const float f = g1 / fmaxf(lt, 1e-30f);
#pragma unroll
            for (int dt = 0; dt < 2; ++dt)
#pragma unroll
                for (int r = 0; r < 16; ++r) { otot[dt][r] += f * o[dt][r]; o[dt][r] = 0.f; }
            lsum = 0.f; prevtype = type;
        }
        int kloA, khiA, kloB = 0, khiB = -1;
        if (type == 0) { kloA = 0; khiA = ((mymask >> jA) & 1u) ? (jA == tb ? tok : 63) : -1; if (hasB) khiB = ((mymask >> jB) & 1u) ? (jB == tb ? tok : 63) : -1; }
        else { kloA = (jA == tb - 4) ? tok + 1 : 0; khiA = (jA == tb) ? tok : 63; if (hasB) { kloB = (jB == tb - 4) ? tok + 1 : 0; khiB = (jB == tb) ? tok : 63; } }
        const bool colA = khiA >= kloA, colB = khiB >= kloB;
        if (__any(colA || colB)) {
            const LAS unsigned char* kt_ = sb; const LAS unsigned char* vt_ = sb + 18432;
            f32x16 p0 = (f32x16){}, p1 = (f32x16){}, p2 = (f32x16){}, p3 = (f32x16){};
            __builtin_amdgcn_s_setprio(1);
#pragma unroll
            for (int ks = 0; ks < 4; ++ks) {
                const bf16x8 k0 = *(const LAS bf16x8*)(kt_ + c * KST + (16 * ks + 8 * hi) * 2), k1 = *(const LAS bf16x8*)(kt_ + (c + 32) * KST + (16 * ks + 8 * hi) * 2);
                p0 = __builtin_amdgcn_mfma_f32_32x32x16_bf16(k0, qf[ks], p0, 0, 0, 0); p1 = __builtin_amdgcn_mfma_f32_32x32x16_bf16(k1, qf[ks], p1, 0, 0, 0);
            }
            if (hasB) {
#pragma unroll
                for (int ks = 0; ks < 4; ++ks) {
                    const bf16x8 k2 = *(const LAS bf16x8*)(kt_ + (c + 64) * KST + (16 * ks + 8 * hi) * 2), k3 = *(const LAS bf16x8*)(kt_ + (c + 96) * KST + (16 * ks + 8 * hi) * 2);
                    p2 = __builtin_amdgcn_mfma_f32_32x32x16_bf16(k2, qf[ks], p2, 0, 0, 0); p3 = __builtin_amdgcn_mfma_f32_32x32x16_bf16(k3, qf[ks], p3, 0, 0, 0);
                }
            }
            __builtin_amdgcn_s_setprio(0);
            if ((jA == tb) || (type == 1 && jA == tb - 4)) {
#pragma unroll
                for (int r = 0; r < 16; ++r) { const int k0 = crow(r, hi), k1 = k0 + 32;
                    p0[r] = (k0 >= kloA && k0 <= khiA) ? p0[r] : -INFINITY; p1[r] = (k1 >= kloA && k1 <= khiA) ? p1[r] : -INFINITY; }
            }
            if (hasB && ((jB == tb) || (type == 1 && jB == tb - 4))) {
#pragma unroll
                for (int r = 0; r < 16; ++r) { const int k0 = crow(r, hi), k1 = k0 + 32;
                    p2[r] = (k0 >= kloB && k0 <= khiB) ? p2[r] : -INFINITY; p3[r] = (k1 >= kloB && k1 <= khiB) ? p3[r] : -INFINITY; }
            }
            const float mrefA = colA ? shiftc : INFINITY;
            const pg8::f32x2_t mrA = {mrefA, mrefA}; pg8::f32x2_t ps0 = {0.f, 0.f}, ps1 = {0.f, 0.f};
#pragma unroll
            for (int r = 0; r < 16; r += 2) { pg8::f32x2_t v0 = {p0[r], p0[r + 1]}, v1 = {p1[r], p1[r + 1]}; v0 -= mrA; v1 -= mrA;
                v0.x = __builtin_amdgcn_exp2f(v0.x); v0.y = __builtin_amdgcn_exp2f(v0.y); v1.x = __builtin_amdgcn_exp2f(v1.x); v1.y = __builtin_amdgcn_exp2f(v1.y);
                ps0 += v0; ps1 += v1; p0[r] = v0.x; p0[r + 1] = v0.y; p1[r] = v1.x; p1[r + 1] = v1.y; }
            { const pg8::f32x2_t pt = ps0 + ps1; lsum += pt.x + pt.y; }
#pragma unroll
            for (int s = 0; s < 4; ++s) pv_step(o, vt_, s, (s < 2) ? pack8(p0, 8 * (s & 1)) : pack8(p1, 8 * (s & 1)), lane);
            if (hasB) {
                const float mrefB = colB ? shiftc : INFINITY;
                const pg8::f32x2_t mrB = {mrefB, mrefB}; pg8::f32x2_t ps2 = {0.f, 0.f}, ps3 = {0.f, 0.f};
#pragma unroll
                for (int r = 0; r < 16; r += 2) { pg8::f32x2_t v0 = {p2[r], p2[r + 1]}, v1 = {p3[r], p3[r + 1]}; v0 -= mrB; v1 -= mrB;
                    v0.x = __builtin_amdgcn_exp2f(v0.x); v0.y = __builtin_amdgcn_exp2f(v0.y); v1.x = __builtin_amdgcn_exp2f(v1.x); v1.y = __builtin_amdgcn_exp2f(v1.y);
                    ps2 += v0; ps3 += v1; p2[r] = v0.x; p2[r + 1] = v0.y; p3[r] = v1.x; p3[r + 1] = v1.y; }
                { const pg8::f32x2_t pt = ps2 + ps3; lsum += pt.x + pt.y; }
#pragma unroll
                for (int s = 0; s < 4; ++s) pv_step(o, vt_, 4 + s, (s < 2) ? pack8(p2, 8 * (s & 1)) : pack8(p3, 8 * (s & 1)), lane);
            }
        }
        buf ^= 1; curA = nxtA; curB = nxtB;
    }
    {
        const float lt = lsum + __shfl_xor(lsum, 32); const float f = g2 / fmaxf(lt, 1e-30f);
#pragma unroll
        for (int dt = 0; dt < 2; ++dt)
#pragma unroll
            for (int r = 0; r < 16; ++r) otot[dt][r] += f * o[dt][r];
    }
    bf16_t* orow = (bf16_t*)(a.ws + WS_MIX) + (rowbase + t) * DM + 512 + (g * 4 + h) * 64 + 4 * hi;
#pragma unroll
    for (int dt = 0; dt < 2; ++dt)
#pragma unroll
        for (int gq = 0; gq < 4; ++gq) { u32x2 w; w.x = pg8::cvt_pk_bf16(otot[dt][4 * gq], otot[dt][4 * gq + 1]); w.y = pg8::cvt_pk_bf16(otot[dt][4 * gq + 2], otot[dt][4 * gq + 3]);
            *(u32x2*)(orow + 32 * dt + 8 * gq) = w; }
#undef NSA_LOAD_TILE
}
__device__ __forceinline__ void phase_nsa_mfma(const KArgs& a, int l, LAS unsigned char* lds, int wave, int lane) {
    const float gq = wave_max(fabsf(a.in[I_QN][l * 64 + lane])), gk = wave_max(fabsf(a.in[I_KN][l * 64 + lane]));
    const float shiftc = __uint_as_float(__builtin_amdgcn_readfirstlane(__float_as_uint(fmaxf(0.f, 64.f * 0.125f * LOG2E * gq * gk - 60.f))));
    for (int it = blockIdx.x; it < NB * 2 * 32; it += gridDim.x) {
        const int k = it >> 8, pos = it & 255, grp = pos >> 6, bg = pos & 63;
        const int tq = 31 - (4 * k + ((k & 1) ? 3 - grp : grp));
        nsa_mfma_item(a, l, bg >> 1, bg & 1, tq, lds, wave, lane, shiftc);
    }
}

constexpr int N2_IMP = 43008, N2_SEL = 59392, N2_UNI = 59904, N2_OTP = 60416;
__device__ __forceinline__ void nsa2_softmax(f32x16& P, int kbase, bool col, bool bnd, int klo, int khi, int hi, float shiftc, float& lsum) {
    if (bnd) {
#pragma unroll
        for (int r = 0; r < 16; ++r) { const int k0 = kbase + crow(r, hi); P[r] = (k0 >= klo && k0 <= khi) ? P[r] : -INFINITY; }
    }
    const float mref = col ? shiftc : INFINITY; const pg8::f32x2_t mr = {mref, mref}; pg8::f32x2_t ps = {0.f, 0.f};
#pragma unroll
    for (int r = 0; r < 16; r += 2) { pg8::f32x2_t v = {P[r], P[r + 1]}; v -= mr; v.x = __builtin_amdgcn_exp2f(v.x); v.y = __builtin_amdgcn_exp2f(v.y); ps += v; P[r] = v.x; P[r + 1] = v.y; }
    lsum += ps.x + ps.y;
}
__device__ __forceinline__ void nsa2_item(const KArgs& a, int l, int b, int g, int T, LAS unsigned char* lds, int wave, int lane_in, float shiftc) {
    (void)lane_in; int lane = (int)__builtin_amdgcn_mbcnt_hi(~0u, __builtin_amdgcn_mbcnt_lo(~0u, 0u)); asm volatile("" : "+v"(lane));
    const int tid = wave * 64 + lane;
    const bf16_t* Z = (const bf16_t*)(a.ws + WS_Z);
    const int t0 = T * 128; const size_t rowbase = (size_t)b * SEQ;
    const int c = lane & 31, hi = lane >> 5, tl = c >> 2, h = c & 3;
    const int tok = 8 * wave + tl;
    __syncthreads();
    {
        const bf16_t* kc = (const bf16_t*)(a.ws + WS_KCMP) + (size_t)((b * 2 + g) * 128) * 64;
        const bf16_t* vc = (const bf16_t*)(a.ws + WS_VCMP) + (size_t)((b * 2 + g) * 128) * 64;
#pragma unroll
        for (int r = 0; r < 2; ++r) { const int e = tid + r * NTHREADS, key = e >> 3, ch = e & 7;
            const u32x4 kk = *(const u32x4*)(kc + key * 64 + ch * 8), vv = *(const u32x4*)(vc + key * 64 + ch * 8);
            *(LAS u32x4*)(lds + L_KC + key * KST + ch * 16) = kk; *(LAS u32x4*)(lds + L_VC + key * VST + ch * 16) = vv; }
    }
    const int skey = tid >> 3, sch = tid & 7;
    u32x4 kreg, vreg;
    const bf16_t* ksn = (const bf16_t*)(a.ws + WS_KSN); const bf16_t* kwn = (const bf16_t*)(a.ws + WS_KWN);
#define N2_LOAD_TILE(idx) do { const int ty_ = (idx) >> 5, j_ = (idx) & 31; const size_t row_ = rowbase + 64 * j_ + skey; \
        kreg = *(const u32x4*)((ty_ ? kwn : ksn) + row_ * 128 + g * 64 + sch * 8); \
        vreg = *(const u32x4*)(Z + row_ * ZW + (ty_ ? ZC_VW : ZC_VS) + g * 64 + sch * 8); } while (0)
    N2_LOAD_TILE(0);
    bf16x8 qf[2][4]; float g0[2]; unsigned g12[2];
    __syncthreads();
    LAS unsigned* otp = (LAS unsigned*)(lds + N2_OTP) + tid;
    unsigned uniw = 0u;
#pragma unroll
    for (int s = 0; s < 2; ++s) {
        {
        const bf16_t* zrow = Z + (rowbase + t0 + 64 * s + tok) * ZW;
        u32x4 raw[4]; float ss = 0.f;
#pragma unroll
        for (int ks = 0; ks < 4; ++ks) { raw[ks] = *(const u32x4*)(zrow + ZC_NQ + g * 256 + h * 64 + 16 * ks + 8 * hi);
#pragma unroll
            for (int i = 0; i < 4; ++i) { const float x0 = bf2f(raw[ks][i] & 0xffff), x1 = bf2f(raw[ks][i] >> 16); ss += x0 * x0 + x1 * x1; } }
        ss = x32_sum(ss);
        const float rs = rsqrtf(ss * (1.f / 64.f) + EPS) * (0.125f * LOG2E);
#pragma unroll
        for (int ks = 0; ks < 4; ++ks) { const float* gp = a.in[I_QN] + l * 64 + 16 * ks + 8 * hi; const f32x4 ga = *(const f32x4*)gp, gb = *(const f32x4*)(gp + 4);
            u32x4 w;
            w.x = pg8::cvt_pk_bf16(bf2f(raw[ks][0] & 0xffff) * rs * ga[0], bf2f(raw[ks][0] >> 16) * rs * ga[1]);
            w.y = pg8::cvt_pk_bf16(bf2f(raw[ks][1] & 0xffff) * rs * ga[2], bf2f(raw[ks][1] >> 16) * rs * ga[3]);
            w.z = pg8::cvt_pk_bf16(bf2f(raw[ks][2] & 0xffff) * rs * gb[0], bf2f(raw[ks][2] >> 16) * rs * gb[1]);
            w.w = pg8::cvt_pk_bf16(bf2f(raw[ks][3] & 0xffff) * rs * gb[2], bf2f(raw[ks][3] >> 16) * rs * gb[3]);
            if (s == 1 && ks == 3) *(LAS u32x4*)(lds + 125952 + tid * 16) = w; else qf[s][ks] = __builtin_bit_cast(bf16x8, w); }
        const bf16_t* gp = zrow + ZC_NG + (g * 4 + h) * 3;
        g0[s] = 1.f / (1.f + __expf(-bf2f(gp[0])));
        g12[s] = pg8::cvt_pk_bf16(1.f / (1.f + __expf(-bf2f(gp[1]))), 1.f / (1.f + __expf(-bf2f(gp[2]))));
        }
        const int t = t0 + 64 * s + tok, tb = 2 * T + s;
        f32x16 pc[4];
#pragma unroll
        for (int kt = 0; kt < 4; ++kt) { pc[kt] = (f32x16){};
#pragma unroll
            for (int ks = 0; ks < 4; ++ks) { const bf16x8 kf = *(const LAS bf16x8*)(lds + L_KC + (32 * kt + c) * KST + (16 * ks + 8 * hi) * 2);
                pc[kt] = __builtin_amdgcn_mfma_f32_32x32x16_bf16(kf, (s == 1 && ks == 3) ? *(const LAS bf16x8*)(lds + 125952 + tid * 16) : qf[s][ks], pc[kt], 0, 0, 0); } }
        const int nvis = (t >= 31) ? (((t - 31) >> 4) + 1) : 0;
        float mx = -1e30f;
#pragma unroll
        for (int kt = 0; kt < 4; ++kt)
#pragma unroll
            for (int r = 0; r < 16; ++r) { const int n = 32 * kt + crow(r, hi); const float sv = (n < nvis) ? pc[kt][r] : -INFINITY; pc[kt][r] = sv; mx = fmaxf(mx, sv); }
        mx = x32_max(mx);
        float sum = 0.f;
#pragma unroll
        for (int kt = 0; kt < 4; ++kt)
#pragma unroll
            for (int r = 0; r < 16; ++r) { const float p = __builtin_amdgcn_exp2f(pc[kt][r] - mx); pc[kt][r] = p; sum += p; }
        sum = x32_sum(sum);
        const float inv = 1.f / fmaxf(sum, 1e-30f);
#pragma unroll
        for (int kt = 0; kt < 4; ++kt)
#pragma unroll
            for (int r = 0; r < 16; ++r) pc[kt][r] *= inv;
        LAS float* impA = (LAS float*)(lds + N2_IMP + wave * 2048); LAS float* impC = impA + 256;
        LDS_FENCE();
#pragma unroll
        for (int kt = 0; kt < 4; ++kt)
#pragma unroll
            for (int gq = 0; gq < 4; ++gq) {
                float A = pc[kt][4 * gq] + pc[kt][4 * gq + 1] + pc[kt][4 * gq + 2] + 0.5f * pc[kt][4 * gq + 3], C = 0.5f * pc[kt][4 * gq + 3];
                A += swz_f<1>(A); A += swz_f<2>(A); C += swz_f<1>(C); C += swz_f<2>(C);
                const int j = 8 * kt + 2 * gq + hi;
                if (h == 0) { impA[tl * 32 + j] = A; if (j < 31) impC[tl * 32 + j + 1] = C; }
            }
        if (h == 0 && hi == 0) impC[tl * 32] = 0.f;
        f32x16 oc[2]; oc[0] = (f32x16){}; oc[1] = (f32x16){};
#pragma unroll
        for (int s8 = 0; s8 < 8; ++s8) pv_step(oc, lds + L_VC, s8, pack8(pc[s8 >> 1], 8 * (s8 & 1)), lane);
#pragma unroll
        for (int dt = 0; dt < 2; ++dt)
#pragma unroll
            for (int r = 0; r < 16; r += 2) otp[(16 * s + 8 * dt + (r >> 1)) * 512] = pg8::cvt_pk_bf16(g0[s] * oc[dt][r], g0[s] * oc[dt][r + 1]);
        LDS_FENCE();
        const int tk = lane >> 3, jg = lane & 7;
        const LAS float* ia = impA + tk * 32; const LAS float* ic = impC + tk * 32;
        float sc[32];
#pragma unroll
        for (int q4 = 0; q4 < 8; ++q4) { const f32x4 x = *(const LAS f32x4*)(ia + 4 * q4) + *(const LAS f32x4*)(ic + 4 * q4);
#pragma unroll
            for (int u = 0; u < 4; ++u) { const int j = 4 * q4 + u; const bool forced = (j == 0) || (j == tb) || (j == tb - 1); sc[j] = (j <= tb) ? (x[u] + (forced ? 1e4f : 0.f)) : -1.0f; } }
        float so[4];
        { const f32x4 x = *(const LAS f32x4*)(ia + 4 * jg) + *(const LAS f32x4*)(ic + 4 * jg);
#pragma unroll
            for (int u = 0; u < 4; ++u) { const int j = 4 * jg + u; const bool forced = (j == 0) || (j == tb) || (j == tb - 1); so[u] = (j <= tb) ? (x[u] + (forced ? 1e4f : 0.f)) : -1.0f; } }
        unsigned part = 0u;
#pragma unroll
        for (int u = 0; u < 4; ++u) { const int j = 4 * jg + u; int rank = 0;
#pragma unroll
            for (int jj = 0; jj < 32; ++jj) rank += (sc[jj] > so[u] || (sc[jj] == so[u] && jj < j)) ? 1 : 0;
            part |= (rank < 8 ? 1u : 0u) << j; }
        part |= swz_u<1>(part); part |= swz_u<2>(part); part |= swz_u<4>(part);
        LAS unsigned* selm = (LAS unsigned*)(lds + N2_SEL) + s * 64;
        if (jg == 0) selm[wave * 8 + tk] = part;
        unsigned uni = part; uni |= swz_u<8>(uni); uni |= swz_u<16>(uni); uni = x32_or(uni);
        uniw |= uni & ((2u << tb) - 1u);
        LDS_FENCE();
        __builtin_amdgcn_sched_barrier(0);
    }
    LDS_FENCE();
    *(LAS bf16x8*)(lds + N2_IMP + wave * 2048 + lane * 16) = qf[1][2];
    if (lane == 0) ((LAS unsigned*)(lds + N2_UNI))[wave] = uniw;
    __syncthreads();
    unsigned uniall = 0u;
    { const LAS unsigned* up = (const LAS unsigned*)(lds + N2_UNI);
#pragma unroll
        for (int w = 0; w < 8; ++w) uniall |= up[w]; }
    uniall = __builtin_amdgcn_readfirstlane(uniall);
    const int tb0 = 2 * T, tb1 = 2 * T + 1;
    const unsigned upto = (2u << tb1) - 1u;
    const int wlo = tb0 - 4 > 0 ? tb0 - 4 : 0;
    unsigned long long list = (unsigned long long)(uniall & upto) | ((unsigned long long)(upto & ~((1u << wlo) - 1u)) << 32);
    float lsum[2] = {0.f, 0.f}; f32x16 o[2][2];
#pragma unroll
    for (int s = 0; s < 2; ++s) { o[s][0] = (f32x16){}; o[s][1] = (f32x16){}; }
    int cur = 0; list &= list - 1ull;
    int buf = 0, prevtype = 0;
    while (cur >= 0) {
        LAS unsigned char* sb = lds + buf * 21504;
        *(LAS u32x4*)(sb + skey * KST + sch * 16) = kreg; *(LAS u32x4*)(sb + 9216 + skey * VST + sch * 16) = vreg;
        __syncthreads();
        int nxt = -1;
        if (list) { nxt = __builtin_ctzll(list); list &= list - 1ull; N2_LOAD_TILE(nxt); }
        const int type = cur >> 5, j = cur & 31;
        if (type != prevtype) {
#pragma unroll
            for (int s = 0; s < 2; ++s) {
                const float lt = x32_sum(lsum[s]); const float f = __uint_as_float(g12[s] << 16) / fmaxf(lt, 1e-30f);
#pragma unroll
                for (int dt = 0; dt < 2; ++dt)
#pragma unroll
                    for (int r = 0; r < 16; r += 2) { const unsigned w = otp[(16 * s + 8 * dt + (r >> 1)) * 512];
                        otp[(16 * s + 8 * dt + (r >> 1)) * 512] = pg8::cvt_pk_bf16(__uint_as_float(w << 16) + f * o[s][dt][r], __uint_as_float(w & 0xffff0000u) + f * o[s][dt][r + 1]); o[s][dt][r] = 0.f; o[s][dt][r + 1] = 0.f; }
                lsum[s] = 0.f; }
            prevtype = type;
        }
        int klo[2], khi[2]; bool col[2], bnd[2], act[2];
#pragma unroll
        for (int s = 0; s < 2; ++s) { const int tb = 2 * T + s;
            if (type == 0) { const unsigned mm_ = ((const LAS unsigned*)(lds + N2_SEL))[s * 64 + wave * 8 + tl]; klo[s] = 0; khi[s] = (j <= tb && ((mm_ >> j) & 1u)) ? (j == tb ? tok : 63) : -1; bnd[s] = (j == tb); }
            else { const bool in = (j <= tb) && (j >= tb - 4); klo[s] = (j == tb - 4) ? tok + 1 : 0; khi[s] = in ? ((j == tb) ? tok : 63) : -1; bnd[s] = (j == tb) || (j == tb - 4); }
            col[s] = khi[s] >= klo[s]; act[s] = __any(col[s]); }
        if (act[0] || act[1]) {
            const LAS unsigned char* kt_ = sb; const LAS unsigned char* vt_ = sb + 9216;
            const int i = lane & 15, dh = (lane >> 4) & 1;
#pragma unroll
            for (int sub = 0; sub < 2; ++sub) {
                f32x16 p[2]; p[0] = (f32x16){}; p[1] = (f32x16){};
#pragma unroll
                for (int ks = 0; ks < 4; ++ks) {
                    const bf16x8 kf = *(const LAS bf16x8*)(kt_ + (c + 32 * sub) * KST + (16 * ks + 8 * hi) * 2);
#pragma unroll
                    for (int s = 0; s < 2; ++s) if (act[s]) p[s] = __builtin_amdgcn_mfma_f32_32x32x16_bf16(kf, (s == 1 && ks == 3) ? *(const LAS bf16x8*)(lds + 125952 + tid * 16) : (s == 1 && ks == 2) ? *(const LAS bf16x8*)(lds + N2_IMP + wave * 2048 + lane * 16) : qf[s][ks], p[s], 0, 0, 0);
                }
#pragma unroll
                for (int s = 0; s < 2; ++s) if (act[s]) nsa2_softmax(p[s], 32 * sub, col[s], bnd[s], klo[s], khi[s], hi, shiftc, lsum[s]);
#pragma unroll
                for (int s4 = 2 * sub; s4 < 2 * sub + 2; ++s4) {
                    const LAS unsigned char* pvp = vt_ + (16 * s4 + 4 * hi + (i >> 2)) * VST + (16 * dh + 4 * (i & 3)) * 2;
                    bf16x8 bfr[2];
#pragma unroll
                    for (int s = 0; s < 2; ++s) bfr[s] = pack8(p[s], 8 * (s4 & 1));
#pragma unroll
                    for (int dt = 0; dt < 2; ++dt) {
                        const s16x4 lo = tr_read(pvp + dt * 64), hh = tr_read(pvp + dt * 64 + 8 * VST);
                        const bf16x8 af = (bf16x8){lo[0], lo[1], lo[2], lo[3], hh[0], hh[1], hh[2], hh[3]};
#pragma unroll
                        for (int s = 0; s < 2; ++s) if (act[s]) o[s][dt] = __builtin_amdgcn_mfma_f32_32x32x16_bf16(af, bfr[s], o[s][dt], 0, 0, 0);
                    }
                }
            }
        }
        buf ^= 1; cur = nxt;
    }
#pragma unroll
    for (int s = 0; s < 2; ++s) {
        const float lt = x32_sum(lsum[s]); const float f = __uint_as_float(g12[s] & 0xffff0000u) / fmaxf(lt, 1e-30f);
        bf16_t* orow = (bf16_t*)(a.ws + WS_MIX) + (rowbase + t0 + 64 * s + tok) * DM + 512 + (g * 4 + h) * 64 + 4 * hi;
#pragma unroll
        for (int dt = 0; dt < 2; ++dt)
#pragma unroll
            for (int gq = 0; gq < 4; ++gq) { u32x2 w;
                const unsigned w0 = otp[(16 * s + 8 * dt + 2 * gq) * 512], w1 = otp[(16 * s + 8 * dt + 2 * gq + 1) * 512];
                w.x = pg8::cvt_pk_bf16(__uint_as_float(w0 << 16) + f * o[s][dt][4 * gq], __uint_as_float(w0 & 0xffff0000u) + f * o[s][dt][4 * gq + 1]);
                w.y = pg8::cvt_pk_bf16(__uint_as_float(w1 << 16) + f * o[s][dt][4 * gq + 2], __uint_as_float(w1 & 0xffff0000u) + f * o[s][dt][4 * gq + 3]);
                *(u32x2*)(orow + 32 * dt + 8 * gq) = w; }
    }
#undef N2_LOAD_TILE
}
__device__ __forceinline__ void phase_nsa2(const KArgs& a, int l, LAS unsigned char* lds, int wave, int lane) {
    const float gq = wave_max(fabsf(a.in[I_QN][l * 64 + lane])), gk = wave_max(fabsf(a.in[I_KN][l * 64 + lane]));
    const float shiftc = __uint_as_float(__builtin_amdgcn_readfirstlane(__float_as_uint(fmaxf(0.f, 64.f * 0.125f * LOG2E * gq * gk - 60.f))));
    for (int it = blockIdx.x; it < NB * 2 * 16; it += gridDim.x) {
        const int k = it >> 8, pos = it & 255, grp = pos >> 6, bg = pos & 63;
        const int T = 15 - (4 * k + ((k & 1) ? 3 - grp : grp));
        nsa2_item(a, l, bg >> 1, bg & 1, T, lds, wave, lane, shiftc);
    }
}

constexpr int R_Q = 0, R_K = 18432, R_V = 36864, R_ST = 61440;
__device__ __forceinline__ void ret_mfma_item(const KArgs& a, int l, int bh, LAS unsigned char* lds, int wave, int lane_in) {
    int lane = lane_in; asm volatile("" : "+v"(lane));
    const int tid = wave * 64 + lane, b = bh >> 2, h = bh & 3;
    const float l2g = (h == 0) ? -0.04580368961312479f : (h == 1) ? -0.02272007650008353f : (h == 2) ? -0.011315313227834146f : -0.005646563141142062f;
    const float gamma = 1.0f - exp2f(-5.0f - (float)h), g127 = exp2f(127.f * l2g), g128 = exp2f(128.f * l2g);
    const bf16_t* Z = (const bf16_t*)(a.ws + WS_Z);
    const float* cs = (const float*)(a.ws + WS_CS);
    const int sc_ = tid >> 2, part = tid & 3, d0 = 16 * part;
    const float dq = exp2f((float)sc_ * l2g), dk = 0.125f * exp2f(-(float)sc_ * l2g);
    __syncthreads();
    for (int e = tid; e < 576; e += NTHREADS) *(LAS u32x4*)(lds + R_ST + e * 16) = (u32x4){0u, 0u, 0u, 0u};
    u32x4 qraw[2], kraw[2], vraw[2]; f32x4 csv[4];
#define RET_PREFETCH(n) do { const size_t pos_ = (size_t)(n) * 128 + sc_; const bf16_t* zr_ = Z + ((size_t)b * SEQ + pos_) * ZW + h * 64 + d0; \
        qraw[0] = *(const u32x4*)(zr_ + ZC_RQ); qraw[1] = *(const u32x4*)(zr_ + ZC_RQ + 8); kraw[0] = *(const u32x4*)(zr_ + ZC_RK); kraw[1] = *(const u32x4*)(zr_ + ZC_RK + 8); \
        vraw[0] = *(const u32x4*)(zr_ + ZC_RV); vraw[1] = *(const u32x4*)(zr_ + ZC_RV + 8); \
        const f32x4* cp_ = (const f32x4*)(cs + (pos_ * 32 + 8 * part) * 2); csv[0] = cp_[0]; csv[1] = cp_[1]; csv[2] = cp_[2]; csv[3] = cp_[3]; } while (0)
    RET_PREFETCH(0);
    f32x16 sacc = (f32x16){};
    const int cl = lane & 31, hi = lane >> 5;
    for (int n = 0; n < SEQ / 128; ++n) {
        {
            u32x4 qo[2], ko[2];
#pragma unroll
            for (int w = 0; w < 8; ++w) {
                const unsigned qw = qraw[w >> 2][w & 3], kw = kraw[w >> 2][w & 3];
                const float cv = csv[w >> 1][(w & 1) * 2], sv = csv[w >> 1][(w & 1) * 2 + 1];
                const float q0 = bf2f(qw & 0xffff), q1 = bf2f(qw >> 16), k0 = bf2f(kw & 0xffff), k1 = bf2f(kw >> 16);
                qo[w >> 2][w & 3] = pg8::cvt_pk_bf16((q0 * cv - q1 * sv) * dq, (q1 * cv + q0 * sv) * dq);
                ko[w >> 2][w & 3] = pg8::cvt_pk_bf16((k0 * cv - k1 * sv) * dk, (k1 * cv + k0 * sv) * dk);
            }
            *(LAS u32x4*)(lds + R_Q + sc_ * KST + d0 * 2) = qo[0]; *(LAS u32x4*)(lds + R_Q + sc_ * KST + d0 * 2 + 16) = qo[1];
            *(LAS u32x4*)(lds + R_K + sc_ * KST + d0 * 2) = ko[0]; *(LAS u32x4*)(lds + R_K + sc_ * KST + d0 * 2 + 16) = ko[1];
            *(LAS u32x4*)(lds + R_V + sc_ * VST + d0 * 2) = vraw[0]; *(LAS u32x4*)(lds + R_V + sc_ * VST + d0 * 2 + 16) = vraw[1];
        }
        __syncthreads();
        if (n + 1 < SEQ / 128) RET_PREFETCH(n + 1);
        const LAS unsigned char* stc = lds + R_ST + (n & 1) * 9216; LAS unsigned char* stn = lds + R_ST + ((n + 1) & 1) * 9216;
        if (wave < 4) {
            const int qc = wave;
            const size_t row = (size_t)b * SEQ + (size_t)n * 128 + 32 * qc + cl;
            u32x2 ggv[8];
            { const bf16_t* grow = Z + row * ZW + ZC_RG + h * 64 + 4 * hi;
#pragma unroll
              for (int i = 0; i < 8; ++i) ggv[i] = *(const u32x2*)(grow + 32 * (i >> 2) + 8 * (i & 3)); }
            bf16x8 qf[4];
#pragma unroll
            for (int ks = 0; ks < 4; ++ks) qf[ks] = *(const LAS bf16x8*)(lds + R_Q + (32 * qc + cl) * KST + (16 * ks + 8 * hi) * 2);
            f32x16 o[2];
#pragma unroll
            for (int et = 0; et < 2; ++et) { f32x16 x = (f32x16){};
#pragma unroll
                for (int ks = 0; ks < 4; ++ks) { const bf16x8 af = *(const LAS bf16x8*)(stc + (32 * et + cl) * KST + (16 * ks + 8 * hi) * 2); x = __builtin_amdgcn_mfma_f32_32x32x16_bf16(af, qf[ks], x, 0, 0, 0); }
#pragma unroll
                for (int r = 0; r < 16; ++r) o[et][r] = gamma * x[r]; }
            for (int mt = 0; mt <= qc; ++mt) {
                f32x16 p = (f32x16){};
#pragma unroll
                for (int ks = 0; ks < 4; ++ks) { const bf16x8 af = *(const LAS bf16x8*)(lds + R_K + (32 * mt + cl) * KST + (16 * ks + 8 * hi) * 2); p = __builtin_amdgcn_mfma_f32_32x32x16_bf16(af, qf[ks], p, 0, 0, 0); }
                if (mt == qc) {
#pragma unroll
                    for (int r = 0; r < 16; ++r) p[r] = (crow(r, hi) <= cl) ? p[r] : 0.f; }
                const LAS unsigned char* vt_ = lds + R_V + 32 * mt * VST;
                pv_step(o, vt_, 0, pack8(p, 0), lane); pv_step(o, vt_, 1, pack8(p, 8), lane);
            }
            float ss = 0.f;
#pragma unroll
            for (int et = 0; et < 2; ++et)
#pragma unroll
                for (int r = 0; r < 16; ++r) ss += o[et][r] * o[et][r];
            ss += __shfl_xor(ss, 32);
            const float rstd = rsqrtf(ss * (1.f / 64.f) + EPS);
            bf16_t* orow = (bf16_t*)(a.ws + WS_MIX) + row * DM + h * 64 + 4 * hi;
#pragma unroll
            for (int et = 0; et < 2; ++et)
#pragma unroll
                for (int gq = 0; gq < 4; ++gq) {
                    const u32x2 gg = ggv[et * 4 + gq];
                    const float ga = bf2f(gg.x & 0xffff), gb = bf2f(gg.x >> 16), gc = bf2f(gg.y & 0xffff), gd = bf2f(gg.y >> 16);
                    u32x2 w;
                    w.x = pg8::cvt_pk_bf16(ga / (1.f + __expf(-ga)) * o[et][4 * gq] * rstd, gb / (1.f + __expf(-gb)) * o[et][4 * gq + 1] * rstd);
                    w.y = pg8::cvt_pk_bf16(gc / (1.f + __expf(-gc)) * o[et][4 * gq + 2] * rstd, gd / (1.f + __expf(-gd)) * o[et][4 * gq + 3] * rstd);
                    if (n + qc + cl != 0) *(u32x2*)(orow + 32 * et + 8 * gq) = w;
                }
        } else {
            const int w4 = wave - 4, et = w4 >> 1, dt = w4 & 1, i = lane & 15, dh = (lane >> 4) & 1;
            f32x16 nw = (f32x16){};
            const LAS unsigned char* pv = lds + R_V + (4 * hi + (i >> 2)) * VST + (32 * et + 16 * dh + 4 * (i & 3)) * 2;
            const LAS unsigned char* pk = lds + R_K + (4 * hi + (i >> 2)) * KST + (32 * dt + 16 * dh + 4 * (i & 3)) * 2;
#pragma unroll
            for (int s8 = 0; s8 < 8; ++s8) {
                const s16x4 al = tr_read(pv + 16 * s8 * VST), ah = tr_read(pv + (16 * s8 + 8) * VST);
                const s16x4 bl = tr_read(pk + 16 * s8 * KST), bh2 = tr_read(pk + (16 * s8 + 8) * KST);
                const bf16x8 af = (bf16x8){al[0], al[1], al[2], al[3], ah[0], ah[1], ah[2], ah[3]}, bfr = (bf16x8){bl[0], bl[1], bl[2], bl[3], bh2[0], bh2[1], bh2[2], bh2[3]};
                nw = __builtin_amdgcn_mfma_f32_32x32x16_bf16(af, bfr, nw, 0, 0, 0);
            }
#pragma unroll
            for (int r = 0; r < 16; ++r) { sacc[r] = g128 * sacc[r] + g127 * nw[r];
                *(LAS bf16_t*)(stn + (32 * et + crow(r, hi)) * KST + (32 * dt + cl) * 2) = (bf16_t)f2bf(sacc[r]); }
        }
        __syncthreads();
    }
#undef RET_PREFETCH
}

constexpr size_t WS_KV = 864 * MiB;
__device__ __forceinline__ float ret_l2g(int h) { return (h == 0) ? -0.04580368961312479f : (h == 1) ? -0.02272007650008353f : (h == 2) ? -0.011315313227834146f : -0.005646563141142062f; }
struct RetRaw { u32x4 q[2], k[2], v[2]; f32x4 cs[4]; };
template <bool WITH_Q> __device__ __forceinline__ void ret_load_chunk(const KArgs& a, int b, int h, int n, int tid, RetRaw& R) {
    const bf16_t* Z = (const bf16_t*)(a.ws + WS_Z); const float* cs = (const float*)(a.ws + WS_CS);
    const int sc_ = tid >> 2, part = tid & 3, d0 = 16 * part;
    const size_t pos = (size_t)n * 128 + sc_; const bf16_t* zr = Z + ((size_t)b * SEQ + pos) * ZW + h * 64 + d0;
    if (WITH_Q) { R.q[0] = *(const u32x4*)(zr + ZC_RQ); R.q[1] = *(const u32x4*)(zr + ZC_RQ + 8); }
    R.k[0] = *(const u32x4*)(zr + ZC_RK); R.k[1] = *(const u32x4*)(zr + ZC_RK + 8); R.v[0] = *(const u32x4*)(zr + ZC_RV); R.v[1] = *(const u32x4*)(zr + ZC_RV + 8);
    const f32x4* cp = (const f32x4*)(cs + (pos * 32 + 8 * part) * 2); R.cs[0] = cp[0]; R.cs[1] = cp[1]; R.cs[2] = cp[2]; R.cs[3] = cp[3];
}
template <bool WITH_Q> __device__ __forceinline__ void ret_store_chunk(const RetRaw& R, int h, LAS unsigned char* lds, int tid) {
    const float l2g = ret_l2g(h);
    const int sc_ = tid >> 2, part = tid & 3, d0 = 16 * part;
    const float dq = exp2f((float)sc_ * l2g), dk = 0.125f * exp2f(-(float)sc_ * l2g);
    u32x4 qo[2], ko[2];
#pragma unroll
    for (int w = 0; w < 8; ++w) {
        const float cv = R.cs[w >> 1][(w & 1) * 2], sv = R.cs[w >> 1][(w & 1) * 2 + 1];
        const unsigned kw = R.k[w >> 2][w & 3]; const float k0 = bf2f(kw & 0xffff), k1 = bf2f(kw >> 16);
        ko[w >> 2][w & 3] = pg8::cvt_pk_bf16((k0 * cv - k1 * sv) * dk, (k1 * cv + k0 * sv) * dk);
        if (WITH_Q) { const unsigned qw = R.q[w >> 2][w & 3]; const float q0 = bf2f(qw & 0xffff), q1 = bf2f(qw >> 16);
            qo[w >> 2][w & 3] = pg8::cvt_pk_bf16((q0 * cv - q1 * sv) * dq, (q1 * cv + q0 * sv) * dq); }
    }
    if (WITH_Q) { *(LAS u32x4*)(lds + R_Q + sc_ * KST + d0 * 2) = qo[0]; *(LAS u32x4*)(lds + R_Q + sc_ * KST + d0 * 2 + 16) = qo[1]; }
    *(LAS u32x4*)(lds + R_K + sc_ * KST + d0 * 2) = ko[0]; *(LAS u32x4*)(lds + R_K + sc_ * KST + d0 * 2 + 16) = ko[1];
    *(LAS u32x4*)(lds + R_V + sc_ * VST + d0 * 2) = R.v[0]; *(LAS u32x4*)(lds + R_V + sc_ * VST + d0 * 2 + 16) = R.v[1];
}
__device__ __forceinline__ void retkv_item(const KArgs& a, int l, int item, int next_item, RetRaw& R, LAS unsigned char* lds, int wave, int lane_in) {
    int lane = lane_in; asm volatile("" : "+v"(lane));
    const int tid = wave * 64 + lane, n = item & 15, bh = item >> 4, h = bh & 3;
    __syncthreads();
    ret_store_chunk<false>(R, h, lds, tid);
    if (next_item >= 0) ret_load_chunk<false>(a, (next_item >> 4) >> 2, (next_item >> 4) & 3, next_item & 15, tid, R);
    __syncthreads();
    if (wave < 4) {
        const int et = wave >> 1, dt = wave & 1, i = lane & 15, dh = (lane >> 4) & 1, hi = lane >> 5, cl = lane & 31;
        f32x16 nw = (f32x16){};
        const LAS unsigned char* pv = lds + R_V + (4 * hi + (i >> 2)) * VST + (32 * et + 16 * dh + 4 * (i & 3)) * 2;
        const LAS unsigned char* pk = lds + R_K + (4 * hi + (i >> 2)) * KST + (32 * dt + 16 * dh + 4 * (i & 3)) * 2;
#pragma unroll
        for (int s8 = 0; s8 < 8; ++s8) {
            const s16x4 al = tr_read(pv + 16 * s8 * VST), ah = tr_read(pv + (16 * s8 + 8) * VST);
            const s16x4 bl = tr_read(pk + 16 * s8 * KST), bh2 = tr_read(pk + (16 * s8 + 8) * KST);
            const bf16x8 af = (bf16x8){al[0], al[1], al[2], al[3], ah[0], ah[1], ah[2], ah[3]}, bfr = (bf16x8){bl[0], bl[1], bl[2], bl[3], bh2[0], bh2[1], bh2[2], bh2[3]};
            nw = __builtin_amdgcn_mfma_f32_32x32x16_bf16(af, bfr, nw, 0, 0, 0);
        }
        float* kv = (float*)(a.ws + WS_KV) + (size_t)item * 4096;
#pragma unroll
        for (int r = 0; r < 16; ++r) kv[(32 * et + crow(r, hi)) * 64 + 32 * dt + cl] = nw[r];
    }
}
__device__ __forceinline__ void retout_item(const KArgs& a, int l, int item, int next_item, RetRaw& R, LAS unsigned char* lds, int wave, int lane_in) {
    int lane = lane_in; asm volatile("" : "+v"(lane));
    const int tid = wave * 64 + lane, n = item & 15, bh = item >> 4, b = bh >> 2, h = bh & 3;
    const float l2g = ret_l2g(h), gamma = 1.0f - exp2f(-5.0f - (float)h);
    const bf16_t* Z = (const bf16_t*)(a.ws + WS_Z);
    __syncthreads();
    {
        const int e = tid >> 3, d8 = (tid & 7) * 8;
        f32x4 s0 = (f32x4){0.f, 0.f, 0.f, 0.f}, s1 = s0;
        const float* kvb = (const float*)(a.ws + WS_KV) + (size_t)(bh * 16) * 4096 + e * 64 + d8;
#pragma unroll 5
        for (int j = 0; j < n; ++j) { const float cf = exp2f(l2g * (float)(128 * (n - 1 - j) + 127));
            const f32x4 x0 = *(const f32x4*)(kvb + (size_t)j * 4096), x1 = *(const f32x4*)(kvb + (size_t)j * 4096 + 4); s0 += cf * x0; s1 += cf * x1; }
        u32x4 w; w.x = pg8::cvt_pk_bf16(s0[0], s0[1]); w.y = pg8::cvt_pk_bf16(s0[2], s0[3]); w.z = pg8::cvt_pk_bf16(s1[0], s1[1]); w.w = pg8::cvt_pk_bf16(s1[2], s1[3]);
        *(LAS u32x4*)(lds + R_ST + e * KST + d8 * 2) = w;
    }
    ret_store_chunk<true>(R, h, lds, tid);
    if (next_item >= 0) ret_load_chunk<true>(a, (next_item >> 4) >> 2, (next_item >> 4) & 3, next_item & 15, tid, R);
    __syncthreads();
    if (wave < 4) {
        const int qc = wave, cl = lane & 31, hi = lane >> 5;
        const LAS unsigned char* stc = lds + R_ST;
        const size_t row = (size_t)b * SEQ + (size_t)n * 128 + 32 * qc + cl;
        u32x2 ggv[8];
        { const bf16_t* grow = Z + row * ZW + ZC_RG + h * 64 + 4 * hi;
#pragma unroll
          for (int i = 0; i < 8; ++i) ggv[i] = *(const u32x2*)(grow + 32 * (i >> 2) + 8 * (i & 3)); }
        bf16x8 qf[4];
#pragma unroll
        for (int ks = 0; ks < 4; ++ks) qf[ks] = *(const LAS bf16x8*)(lds + R_Q + (32 * qc + cl) * KST + (16 * ks + 8 * hi) * 2);
        f32x16 o[2];
#pragma unroll
        for (int et = 0; et < 2; ++et) { f32x16 x = (f32x16){};
#pragma unroll
            for (int ks = 0; ks < 4; ++ks) { const bf16x8 af = *(const LAS bf16x8*)(stc + (32 * et + cl) * KST + (16 * ks + 8 * hi) * 2); x = __builtin_amdgcn_mfma_f32_32x32x16_bf16(af, qf[ks], x, 0, 0, 0); }
#pragma unroll
            for (int r = 0; r < 16; ++r) o[et][r] = gamma * x[r]; }
        for (int mt = 0; mt <= qc; ++mt) {
            f32x16 p = (f32x16){};
#pragma unroll
            for (int ks = 0; ks < 4; ++ks) { const bf16x8 af = *(const LAS bf16x8*)(lds + R_K + (32 * mt + cl) * KST + (16 * ks + 8 * hi) * 2); p = __builtin_amdgcn_mfma_f32_32x32x16_bf16(af, qf[ks], p, 0, 0, 0); }
            if (mt == qc) {
#pragma unroll
                for (int r = 0; r < 16; ++r) p[r] = (crow(r, hi) <= cl) ? p[r] : 0.f; }
            const LAS unsigned char* vt_ = lds + R_V + 32 * mt * VST;
            pv_step(o, vt_, 0, pack8(p, 0), lane); pv_step(o, vt_, 1, pack8(p, 8), lane);
        }
        float ss = 0.f;
#pragma unroll
        for (int et = 0; et < 2; ++et)
#pragma unroll
            for (int r = 0; r < 16; ++r) ss += o[et][r] * o[et][r];
        ss += __shfl_xor(ss, 32);
        const float rstd = rsqrtf(ss * (1.f / 64.f) + EPS);
        bf16_t* orow = (bf16_t*)(a.ws + WS_MIX) + row * DM + h * 64 + 4 * hi;
#pragma unroll
        for (int et = 0; et < 2; ++et)
#pragma unroll
            for (int gq = 0; gq < 4; ++gq) {
                const u32x2 gg = ggv[et * 4 + gq];
                const float ga = bf2f(gg.x & 0xffff), gb = bf2f(gg.x >> 16), gc = bf2f(gg.y & 0xffff), gd = bf2f(gg.y >> 16);
                u32x2 w;
#define SILU_F(x) ((x) * __builtin_amdgcn_rcpf(1.f + __builtin_amdgcn_exp2f(-LOG2E * (x))))
                w.x = pg8::cvt_pk_bf16(SILU_F(ga) * o[et][4 * gq] * rstd, SILU_F(gb) * o[et][4 * gq + 1] * rstd);
                w.y = pg8::cvt_pk_bf16(SILU_F(gc) * o[et][4 * gq + 2] * rstd, SILU_F(gd) * o[et][4 * gq + 3] * rstd);
#undef SILU_F
                if (n + qc + cl != 0) *(u32x2*)(orow + 32 * et + 8 * gq) = w;
            }
    }
}

__device__ __forceinline__ void cmp_mfma_item(const KArgs& a, int l, int item, LAS unsigned char* lds, int wave, int lane_in) {
    int lane = lane_in; asm volatile("" : "+v"(lane));
    const int tid = wave * 64 + lane, kv = item & 1, g = (item >> 1) & 1, b = item >> 2;
    const bf16_t* Z = (const bf16_t*)(a.ws + WS_Z);
    const bf16_t* w1t = (const bf16_t*)(a.ws + WS_W1T) + (size_t)((l * 2 + kv) * 128) * 1024;
    const float* w2 = a.in[kv ? I_W2V : I_W2K] + (size_t)l * 64 * 64;
    const float* cb = (const float*)(a.ws + WS_CB) + (l * 2 + kv) * 64;
    LAS float* Y = (LAS float*)lds;
    LAS float* o1 = Y + 128 * 132;
    LAS float* w2s = o1 + 128 * 64;
    __syncthreads();
    for (int e = tid; e < 1024; e += NTHREADS) *(LAS f32x4*)(w2s + e * 4) = *(const f32x4*)(w2 + e * 4);
    {
        const int mt = wave >> 1, ct0 = (wave & 1) * 2, r = lane & 31, hi = lane >> 5;
        const bf16_t* abase = Z + ((size_t)b * SEQ + 16 * (32 * mt + r)) * ZW + (kv ? ZC_VC : ZC_KC) + g * 64 + 8 * hi;
        const bf16_t* bb0 = w1t + (size_t)(32 * ct0 + r) * 1024 + 8 * hi; const bf16_t* bb1 = bb0 + 32 * 1024;
        f32x16 acc0 = (f32x16){}, acc1 = (f32x16){};
#pragma unroll 8
        for (int ks = 0; ks < 64; ++ks) {
            const bf16x8 af = *(const bf16x8*)(abase + (size_t)(ks >> 2) * ZW + (ks & 3) * 16);
            const bf16x8 b0 = *(const bf16x8*)(bb0 + 16 * ks), b1 = *(const bf16x8*)(bb1 + 16 * ks);
            acc0 = __builtin_amdgcn_mfma_f32_32x32x16_bf16(af, b0, acc0, 0, 0, 0); acc1 = __builtin_amdgcn_mfma_f32_32x32x16_bf16(af, b1, acc1, 0, 0, 0);
        }
#pragma unroll
        for (int rr = 0; rr < 16; ++rr) { const int m = 32 * mt + crow(rr, hi); Y[m * 132 + 32 * ct0 + r] = acc0[rr]; Y[m * 132 + 32 * (ct0 + 1) + r] = acc1[rr]; }
    }
    __syncthreads();
    for (int e = tid; e < 128 * 64; e += NTHREADS) { const int n = e >> 6, j = e & 63;
        float sv = 0.f; if (n < 127) { sv = Y[n * 132 + j] + Y[(n + 1) * 132 + 64 + j] + cb[j]; sv = sv / (1.f + __expf(-sv)); }
        o1[e] = sv; }
    __syncthreads();
    {
        const int n = tid >> 2, jq = (tid & 3) * 16;
        float acc[16];
#pragma unroll
        for (int i = 0; i < 16; ++i) acc[i] = 0.f;
        for (int j = 0; j < 64; ++j) { const float x = o1[n * 64 + j];
#pragma unroll
            for (int q = 0; q < 4; ++q) { const f32x4 w = *(const LAS f32x4*)(w2s + j * 64 + jq + 4 * q); acc[4 * q] += x * w[0]; acc[4 * q + 1] += x * w[1]; acc[4 * q + 2] += x * w[2]; acc[4 * q + 3] += x * w[3]; } }
        if (!kv) { float ss = 0.f;
#pragma unroll
            for (int i = 0; i < 16; ++i) ss += acc[i] * acc[i];
            ss += __shfl_xor(ss, 1); ss += __shfl_xor(ss, 2);
            const float rstd = rsqrtf(ss * (1.f / 64.f) + EPS);
#pragma unroll
            for (int i = 0; i < 16; ++i) acc[i] = acc[i] * rstd * a.in[I_KN][l * 64 + jq + i]; }
        bf16_t* dst = (bf16_t*)(a.ws + (kv ? WS_VCMP : WS_KCMP)) + ((size_t)((b * 2 + g) * 128) + n) * 64 + jq;
        u32x4 w0, w1v;
        w0.x = pk2(acc[0], acc[1]); w0.y = pk2(acc[2], acc[3]); w0.z = pk2(acc[4], acc[5]); w0.w = pk2(acc[6], acc[7]);
        w1v.x = pk2(acc[8], acc[9]); w1v.y = pk2(acc[10], acc[11]); w1v.z = pk2(acc[12], acc[13]); w1v.w = pk2(acc[14], acc[15]);
        if (n >= 127) { w0 = (u32x4){0u, 0u, 0u, 0u}; w1v = w0; }
        *(u32x4*)dst = w0; *(u32x4*)(dst + 8) = w1v;
    }
}

__device__ __forceinline__ void ret0_item(const KArgs& a, int l, int item, LAS unsigned char* lds, int wave, int lane) {
    int tid = threadIdx.x; asm volatile("" : "+v"(tid));
    const int b = item >> 2, hh = item & 3;
    const float* xrow = ((l == 0) ? a.in[I_X] : a.out) + (size_t)b * SEQ * DM;
    const float* gain = a.in[I_NORM_MIX] + l * DM;
    const float* W = a.in[I_W_IN] + (size_t)l * DM * INW;
    LAS float* hs = (LAS float*)lds;
    LAS float* red = hs + 1024;
    LAS float* qk = red + 16;
    __syncthreads();
    float ss = 0.f;
    for (int k = tid; k < DM; k += NTHREADS) { const float xv = xrow[k]; ss += xv * xv; hs[k] = xv * gain[k]; }
    ss = wave_sum(ss);
    if (lane == 0) red[wave] = ss;
    __syncthreads();
    float tot = 0.f;
#pragma unroll
    for (int w = 0; w < 8; ++w) tot += red[w];
    const float rstd = rsqrtf(tot * (1.f / DM) + EPS);
    const int d = tid & 63, which = (tid >> 6) & 1, kp = tid >> 7;
    const float* wc = W + (size_t)(kp * 256) * INW + (which ? ZC_RK : ZC_RQ) + hh * 64 + d;
    float acc0 = 0.f, acc1 = 0.f, acc2 = 0.f, acc3 = 0.f;
    for (int k = 0; k < 256; k += 32) {
        float wv[32];
#pragma unroll
        for (int i = 0; i < 32; ++i) wv[i] = wc[(size_t)(k + i) * INW];
#pragma unroll
        for (int i = 0; i < 32; i += 4) { acc0 += hs[kp * 256 + k + i] * wv[i]; acc1 += hs[kp * 256 + k + i + 1] * wv[i + 1]; acc2 += hs[kp * 256 + k + i + 2] * wv[i + 2]; acc3 += hs[kp * 256 + k + i + 3] * wv[i + 3]; }
    }
    qk[tid] = ((acc0 + acc1) + (acc2 + acc3)) * rstd;
    __syncthreads();
    if (wave == 0) {
        const float q0 = (qk[lane] + qk[128 + lane]) + (qk[256 + lane] + qk[384 + lane]), k0 = (qk[64 + lane] + qk[192 + lane]) + (qk[320 + lane] + qk[448 + lane]);
        const float sdot = wave_sum(q0 * k0) * 0.125f;
        const bf16_t* Z = (const bf16_t*)(a.ws + WS_Z);
        const size_t row = (size_t)b * SEQ;
        const float v = bf2f(Z[row * ZW + ZC_RV + hh * 64 + lane]), g = bf2f(Z[row * ZW + ZC_RG + hh * 64 + lane]);
        const float o = sdot * v;
        const float ro = rsqrtf(wave_sum(o * o) * (1.f / 64.f) + EPS);
        ((bf16_t*)(a.ws + WS_MIX))[row * DM + hh * 64 + lane] = (bf16_t)f2bf(g / (1.f + __expf(-g)) * o * ro);
    }
}

constexpr int N_RET = 128, N_CMP = 128, N_CONV = 256, N_KN = 256, N_R0 = 128;
#ifndef RET_MFMA
#define RET_MFMA 1
#endif
constexpr int N_RKV = 2048, N_ROUT = 2048;
__device__ __forceinline__ int ret_item_of(int i) {
    if (gridDim.x != 256) { const int bh = i >> 4; return (bh << 4) | (((i & 15) + 2 * (bh >> 4)) & 15); }
    const int blk = i & 255, k = i >> 8, x = blk & 7, slot = blk >> 3;
    const int q = 2 * k + (slot >> 4), n = ((slot & 15) + 2 * k) & 15, bh = x + 8 * q;
    return (bh << 4) | n;
}
__device__ __forceinline__ void phase_mix1(const KArgs& a, int l, LAS unsigned char* lds, int wave, int lane, int ci) {
    {
        RetRaw R; const int tid0 = wave * 64 + lane;
        int i = blockIdx.x;
        if (i < N_RKV) { const int it = ret_item_of(i); ret_load_chunk<false>(a, (it >> 4) >> 2, (it >> 4) & 3, it & 15, tid0, R); }
        for (; i < N_RKV; i += gridDim.x) { const int nx = i + gridDim.x; retkv_item(a, l, ret_item_of(i), nx < N_RKV ? ret_item_of(nx) : -1, R, lds, wave, lane); }
    }
    unsigned* ctr = (unsigned*)a.ws + ci;
    LAS int* slot = (LAS int*)(lds + LDS_BYTES - 16);
    for (;;) {
        __syncthreads();
        if (threadIdx.x == 0) *slot = (int)atomicAdd(ctr, 1u);
        __syncthreads();
        int r = *slot;
        if (r >= N_R0 + N_CMP + N_CONV + N_KN) break;
        if (r < N_R0) { ret0_item(a, l, r, lds, wave, lane); continue; } r -= N_R0;
        if (r < N_CMP) { cmp_mfma_item(a, l, r, lds, wave, lane); continue; } r -= N_CMP;
        if (r < N_CONV) { conv_item(a, l, r); continue; } r -= N_CONV;
        knorm_item(a, l, r, wave, lane);
    }
}
__device__ __forceinline__ void phase_retout(const KArgs& a, int l, LAS unsigned char* lds, int wave, int lane, int ci) {
    (void)ci;
    RetRaw R; const int tid0 = wave * 64 + lane;
    int i = blockIdx.x;
    if (i < N_ROUT) { const int it = ret_item_of(i); ret_load_chunk<true>(a, (it >> 4) >> 2, (it >> 4) & 3, it & 15, tid0, R); }
    for (; i < N_ROUT; i += gridDim.x) { const int nx = i + gridDim.x; retout_item(a, l, ret_item_of(i), nx < N_ROUT ? ret_item_of(nx) : -1, R, lds, wave, lane); }
}

#define XB_TMO      128
#define XB_XCNT(j)  (256  + 64 * (j))
#define XB_XSUB(j)  (1280 + 64 * (j))
#define XB_XGEN(j)  (2304 + 64 * (j))
#define XB_TOP      3328
#define XB_TOPGEN   3392
#define XCD_BAR_WORDS 3456
#define XB_SPIN_CAP (1u << 18)
constexpr size_t WS_BAR = 65536;
__device__ __forceinline__ unsigned xb_ld(unsigned* p)              { return __hip_atomic_load(p, __ATOMIC_RELAXED, __HIP_MEMORY_SCOPE_AGENT); }
__device__ __forceinline__ unsigned xb_add(unsigned* p, unsigned v) { return __hip_atomic_fetch_add(p, v, __ATOMIC_RELAXED, __HIP_MEMORY_SCOPE_AGENT); }
__device__ __forceinline__ unsigned xb_xcc_id() { return (unsigned)__builtin_amdgcn_s_getreg((3 << 11) | 20) & 0xFu; }
#define XB_SPIN(cond, bar) do { unsigned _sp = 0; while (cond) { __builtin_amdgcn_s_sleep(1); \
    if ((++_sp & 255u) == 0u) { if (xb_ld(&(bar)[XB_TMO])) break; if (_sp > XB_SPIN_CAP) { atomicAdd(&(bar)[XB_TMO], 1u); break; } } } } while (0)
struct XcdBarrier { unsigned* bar; unsigned x; volatile LAS unsigned* st; };
__device__ __forceinline__ XcdBarrier xcd_barrier_post(unsigned* bar, volatile LAS unsigned* st) {
    XcdBarrier b; b.bar = bar; b.x = xb_xcc_id(); b.st = st;
    if (threadIdx.x == 0) (void)xb_add(&bar[XB_XCNT(b.x)], 1u);
    return b;
}
__device__ __forceinline__ void xcd_barrier_complete(unsigned* bar, unsigned x, unsigned& nloc, unsigned& nx) {
    const unsigned G = gridDim.x * gridDim.y * gridDim.z;
    unsigned sum, cnt, mine, sp = 0u;
    for (;;) {
        sum = 0u; cnt = 0u; mine = 0u;
#pragma unroll
        for (unsigned j = 0; j < 16; ++j) { const unsigned c = xb_ld(&bar[XB_XCNT(j)]); sum += c; cnt += (c > 0u) ? 1u : 0u; mine = (j == x) ? c : mine; }
        if (sum == G) break;
        __builtin_amdgcn_s_sleep(1);
        if ((++sp & 255u) == 0u) { if (xb_ld(&bar[XB_TMO])) break; if (sp > XB_SPIN_CAP) { atomicAdd(&bar[XB_TMO], 1u); break; } }
    }
    nloc = mine > 0u ? mine : 1u; nx = cnt > 0u ? cnt : 1u;
}
__device__ __forceinline__ void xcd_barrier(const XcdBarrier& b) {
    asm volatile("s_waitcnt vmcnt(0)" ::: "memory");
    __syncthreads();
    if (threadIdx.x == 0) {
        unsigned* bar = b.bar;
        __builtin_amdgcn_s_waitcnt(0);
        unsigned nloc = b.st[0], nx = b.st[1];
        if (nloc == 0u) { xcd_barrier_complete(bar, b.x, nloc, nx); b.st[0] = nloc; b.st[1] = nx; }
        const unsigned old = xb_add(&bar[XB_XSUB(b.x)], 1u);
        const unsigned gen = old / nloc;
        if (old + 1u == (gen + 1u) * nloc) {
            __builtin_amdgcn_fence(__ATOMIC_RELEASE, "agent");
            asm volatile("s_waitcnt vmcnt(0)" ::: "memory");
            const unsigned og = xb_add(&bar[XB_TOP], 1u);
            const unsigned tg = og / nx;
            if (og + 1u == (tg + 1u) * nx) xb_add(&bar[XB_TOPGEN], 1u);
            else XB_SPIN(xb_ld(&bar[XB_TOPGEN]) == tg, bar);
            __builtin_amdgcn_fence(__ATOMIC_ACQUIRE, "agent");
            xb_add(&bar[XB_XGEN(b.x)], 1u);
            asm volatile("s_waitcnt vmcnt(0)" ::: "memory");
        } else {
            XB_SPIN(xb_ld(&bar[XB_XGEN(b.x)]) == gen, bar);
            __builtin_amdgcn_fence(__ATOMIC_ACQUIRE, "agent");
            asm volatile("s_waitcnt vmcnt(0)" ::: "memory");
        }
    }
    __syncthreads();
}

constexpr int N_PHASES = 1 + 6 * DEPTH;
#ifndef NSA_MFMA
#define NSA_MFMA 1
#endif

#define PH_IN(k) (lo <= (k) && (k) < hi)
#define PH_SEAM(k) do { if (PH_IN(k) && PH_IN((k) + 1)) { xcd_barrier(xbar); if (PROBE & 16) xcd_barrier(xbar); } } while (0)
#define PH_TID() int tid = threadIdx.x; asm volatile("" : "+v"(tid)); const int lane = tid & 63, wave = __builtin_amdgcn_readfirstlane(tid >> 6); (void)lane; (void)wave
template <int L> __device__ __forceinline__ void layer_phases(const KArgs& a, LAS unsigned char* lds, const XcdBarrier& xbar, int lo, int hi) {
    unsigned char* ws = a.ws;
    bf16_t* XB = (bf16_t*)(ws + WS_XN); bf16_t* Zb = (bf16_t*)(ws + WS_Z); bf16_t* Hb = (bf16_t*)(ws + WS_H); bf16_t* MIXb = (bf16_t*)(ws + WS_MIX); float* SSQ = (float*)(ws + WS_SSQ);
    const int G = gridDim.x; constexpr int l = L, P0 = 1 + 6 * L;
    const float* xcur = (l == 0) ? a.in[I_X] : a.out;
    if (PH_IN(P0 + 0)) {
        pg8::Gemm g{XB, (const bf16_t*)(ws + WS_WIN) + (size_t)l * ZW * DM, MTOK, ZW, DM}; pg8::StaticOrder S; S.init(MTOK, ZW, G, (int)blockIdx.x);
        pg8::EpiBf16<0> E{Zb, ZW, SSQ};
        pg8::gemm_phase<pg8::EpiBf16<0>, pg8::StaticOrder, true, true>(lds, g, S, E);
    }
    PH_SEAM(P0 + 0);
    if (PH_IN(P0 + 1)) { PH_TID(); phase_mix1(a, l, lds, wave, lane, l); }
    PH_SEAM(P0 + 1);
    if (PH_IN(P0 + 2)) { PH_TID(); phase_nsa2(a, l, lds, wave, lane); phase_retout(a, l, lds, wave, lane, 4 + l); }
    PH_SEAM(P0 + 2);
    if (PH_IN(P0 + 3)) {
        pg8::Gemm g{MIXb, (const bf16_t*)(ws + WS_WOUT) + (size_t)l * DM * DM, MTOK, DM, DM}; pg8::StaticOrder S; S.init(MTOK, DM, G, (int)blockIdx.x);
        pg8::EpiRes E{xcur, a.out, DM, XB, SSQ};
        pg8::gemm_phase<pg8::EpiRes, pg8::StaticOrder, true, true>(lds, g, S, E);
    }
    PH_SEAM(P0 + 3);
    if (PH_IN(P0 + 4)) {
        pg8::Gemm g{XB, (const bf16_t*)(ws + WS_WUP) + (size_t)l * FF * DM, MTOK, FF, DM}; pg8::StaticOrder S; S.init(MTOK, FF, G, (int)blockIdx.x);
        pg8::EpiBf16<1> E{Hb, FF, SSQ};
        pg8::gemm_phase<pg8::EpiBf16<1>, pg8::StaticOrder, true, true>(lds, g, S, E);
    }
    PH_SEAM(P0 + 4);
    if (PH_IN(P0 + 5)) {
        pg8::Gemm g{Hb, (const bf16_t*)(ws + WS_WDN) + (size_t)l * DM * FF, MTOK, DM, FF}; pg8::StaticOrder S; S.init(MTOK, DM, G, (int)blockIdx.x);
        pg8::EpiRes E{a.out, a.out, DM, (l + 1 < DEPTH) ? XB : nullptr, SSQ};
        pg8::gemm_phase<pg8::EpiRes, pg8::StaticOrder, true, true>(lds, g, S, E);
    }
    PH_SEAM(P0 + 5);
}
__global__ void __launch_bounds__(NTHREADS, 2) fwd_kernel(KArgs a) {
    extern __shared__ __attribute__((aligned(16))) unsigned char lds_raw[];
    LAS unsigned char* lds = (LAS unsigned char*)lds_raw;
    cg::grid_group grid = cg::this_grid();
    const int lo = a.ph_lo, hi = a.ph_hi;
    volatile LAS unsigned* xst = (volatile LAS unsigned*)(lds + LDS_BYTES - 32);
    if (threadIdx.x < 2) xst[threadIdx.x] = 0u;
    __syncthreads();
    const XcdBarrier xbar = xcd_barrier_post((unsigned*)(a.ws + WS_BAR), xst);
    if (hi > 1000) grid.sync();
    {
        PH_TID();
        phase_prologue(a, lds, wave, lane);
        phase_xcvt(a.in[I_X], (bf16_t*)(a.ws + WS_XN), (float*)(a.ws + WS_SSQ), wave, lane);
    }
    xcd_barrier(xbar);
    layer_phases<0>(a, lds, xbar, lo, hi);
    layer_phases<1>(a, lds, xbar, lo, hi);
}

extern "C" void kernel_launch(void* const* d_in, const int* in_sizes, int n_in, void* d_out, int out_size, void* d_ws, size_t ws_size, hipStream_t stream) {
    static int grid = 0;
    if (grid == 0) {
        if (n_in != 16 || in_sizes[0] != MTOK * DM || out_size != MTOK * DM || ws_size < WS_END) {
            fprintf(stderr, "kernel_launch: unexpected shapes (n_in %d, in0 %d, out %d, ws %zu)\n", n_in, n_in > 0 ? in_sizes[0] : -1, out_size, ws_size); grid = -1; return; }
        int dev = 0, cus = 0, per_cu = 0;
        hipGetDevice(&dev); hipDeviceGetAttribute(&cus, hipDeviceAttributeMultiprocessorCount, dev);
        hipFuncSetAttribute((const void*)fwd_kernel, hipFuncAttributeMaxDynamicSharedMemorySize, LDS_BYTES);
        hipOccupancyMaxActiveBlocksPerMultiprocessor(&per_cu, (const void*)fwd_kernel, NTHREADS, LDS_BYTES);
        if (per_cu < 1) { fprintf(stderr, "kernel_launch: occupancy query says %d blocks per CU\n", per_cu); per_cu = 1; }
        (void)hipGetLastError();
        grid = cus * 1;
    }
    if (grid < 0) return;
    KArgs a{};
    for (int i = 0; i < 16; ++i) a.in[i] = (const float*)d_in[i];
    a.out = (float*)d_out; a.ws = (unsigned char*)d_ws; a.ph_lo = 0; a.ph_hi = N_PHASES;
    if (hipMemsetAsync(d_ws, 0, 81920, stream) != hipSuccess) fprintf(stderr, "kernel_launch: memset of the control words failed\n");
    void* args[] = {&a};
    hipError_t e = hipLaunchCooperativeKernel((const void*)fwd_kernel, dim3(grid), dim3(NTHREADS), args, LDS_BYTES, stream);
    if (e != hipSuccess) fprintf(stderr, "cooperative launch failed: %s (grid %d)\n", hipGetErrorString(e), grid);
}
```

```cpp
#include <hip/hip_runtime.h>
#include <hip/hip_cooperative_groups.h>
#include <cstdio>
#include <cstdint>
namespace cg = cooperative_groups;

#define LAS __attribute__((address_space(3)))
typedef unsigned short bf16_t;
typedef short bf16x8 __attribute__((ext_vector_type(8)));
typedef float f32x4 __attribute__((ext_vector_type(4)));
typedef unsigned u32x4 __attribute__((ext_vector_type(4)));
typedef unsigned u32x2 __attribute__((ext_vector_type(2)));

template <int K> __device__ __forceinline__ float swz_f(float v) { return __builtin_bit_cast(float, __builtin_amdgcn_ds_swizzle(__builtin_bit_cast(int, v), (K << 10) | 0x1f)); }
template <int K> __device__ __forceinline__ unsigned swz_u(unsigned v) { return (unsigned)__builtin_amdgcn_ds_swizzle((int)v, (K << 10) | 0x1f); }
__device__ __forceinline__ float x32_sum(float v) { const auto rr = __builtin_amdgcn_permlane32_swap(__float_as_uint(v), __float_as_uint(v), false, false); return __uint_as_float(rr[0]) + __uint_as_float(rr[1]); }
__device__ __forceinline__ float x32_max(float v) { const auto rr = __builtin_amdgcn_permlane32_swap(__float_as_uint(v), __float_as_uint(v), false, false); return fmaxf(__uint_as_float(rr[0]), __uint_as_float(rr[1])); }
__device__ __forceinline__ unsigned x32_or(unsigned v) { const auto rr = __builtin_amdgcn_permlane32_swap(v, v, false, false); return rr[0] | rr[1]; }
namespace pg8 {
#define PG8_LAS __attribute__((address_space(3)))
constexpr int BM = 256, BK = 64, HALF = 128, HTB = HALF * BK * 2, STAGE_BYTES = 8 * HTB, NXCD = 8, WGM = 8;
__host__ __device__ __forceinline__ int lds_byte(int r, int c) { const int st = (r >> 4) * 2 + (c >> 5), rr = r & 15, cc = c & 31, ob = rr * 64 + cc * 2; return st * 1024 + (ob ^ (((ob >> 9) & 1) << 5)); }
__host__ __device__ __forceinline__ void stage_rc(int b, int& R, int& C) { const int st = b / 1024, sb = b % 1024, swz = sb ^ (((sb >> 9) & 1) << 5); R = (st >> 1) * 16 + swz / 64; C = (st & 1) * 32 + (swz % 64) / 2; }
__host__ __device__ __forceinline__ int perm32(int rho) { const int n = rho >> 4, i = rho & 15; return 8 * (i >> 2) + 4 * n + (i & 3); }
struct Unit { int pm, pn; };
struct Gemm { const bf16_t* A; const bf16_t* Bt; int M, N, K; };
struct StaticOrder {
    int nM, nN, nwg, G, c;
    __host__ __device__ void init(int M, int N, int G_, int c_) { nM = M / BM; nN = N / BM; nwg = nM * nN; G = G_; c = c_; }
    __host__ __device__ bool next(int i, Unit& u) const {
        const long L = (long)i * G + c; if (L >= nwg) return false;
        int wgid = (int)L; { const int q = nwg / NXCD, r = nwg % NXCD, xcd = wgid % NXCD, off = wgid / NXCD; wgid = (xcd < r ? xcd * (q + 1) : r * (q + 1) + (xcd - r) * q) + off; }
        const int nig = WGM * nN, gid = wgid / nig, fm = gid * WGM, gsz = (nM - fm) < WGM ? (nM - fm) : WGM;
        u.pm = fm + ((wgid % nig) % gsz); u.pn = (wgid % nig) / gsz; return true;
    }
    __device__ __forceinline__ void a_ready(const Unit&) const {}
    __device__ __forceinline__ void done(const Unit&) const {}
};
typedef float f32x2_t __attribute__((ext_vector_type(2))); typedef __bf16 bf16x2_t __attribute__((ext_vector_type(2)));
__device__ __forceinline__ unsigned cvt_pk_bf16(float lo, float hi) { const f32x2_t v = {lo, hi}; const bf16x2_t b = __builtin_convertvector(v, bf16x2_t); return __builtin_bit_cast(unsigned, b); }

template <int ACT> struct EpiBf16 {
    static constexpr bool PERM = true, AFTER_DRAIN = false, HAS_PRE = true;
    bf16_t* O; int ldc; const float* ssq;
    struct Pre { f32x4 s0, s1, s2, s3; };
    __device__ __forceinline__ Pre pre_load(int pm, int tid) const { Pre p; const f32x4* sp = (const f32x4*)(ssq + (size_t)(pm * BM + (tid & 255)) * 16); p.s0 = sp[0]; p.s1 = sp[1]; p.s2 = sp[2]; p.s3 = sp[3]; return p; }
    __device__ __forceinline__ void pre_store(const Pre& p, PG8_LAS float* tab, int tid) const {
        const float tot = ((p.s0[0] + p.s0[1]) + (p.s0[2] + p.s0[3])) + ((p.s1[0] + p.s1[1]) + (p.s1[2] + p.s1[3])) + ((p.s2[0] + p.s2[1]) + (p.s2[2] + p.s2[3])) + ((p.s3[0] + p.s3[1]) + (p.s3[2] + p.s3[3]));
        if (tid < 256) tab[tid] = rsqrtf(tot * (1.0f / 1024.0f) + 1e-6f);
    }
    __device__ __forceinline__ void operator()(const f32x4 (&acc)[2][2][4][2], const Unit& u, int wr, int wc, int fr, int fq, const PG8_LAS float* tab) const {
        const int rl0 = wr * 64 + fr; const int row0 = u.pm * BM + rl0; const int col0 = u.pn * BM + wc * 32 + 8 * fq;
#pragma unroll
        for (int ai = 0; ai < 2; ++ai)
#pragma unroll
            for (int m = 0; m < 4; ++m) { const int row = row0 + ai * HALF + m * 16; bf16_t* rowp = O + (size_t)row * ldc + col0;
                const float rstd = tab[rl0 + ai * HALF + m * 16];
#pragma unroll
                for (int bj = 0; bj < 2; ++bj) { f32x4 v0 = acc[ai][bj][m][0] * rstd, v1 = acc[ai][bj][m][1] * rstd;
                    if (ACT == 1) {
#pragma unroll
                        for (int e = 0; e < 4; ++e) { float a = v0[e] > 0.f ? v0[e] : 0.f; v0[e] = a * a; float b = v1[e] > 0.f ? v1[e] : 0.f; v1[e] = b * b; } }
                    u32x4 w; w.x = cvt_pk_bf16(v0[0], v0[1]); w.y = cvt_pk_bf16(v0[2], v0[3]); w.z = cvt_pk_bf16(v1[0], v1[1]); w.w = cvt_pk_bf16(v1[2], v1[3]);
                    *(u32x4*)(rowp + bj * HALF) = w; } }
    }
};
struct EpiRes {
    static constexpr bool PERM = true, AFTER_DRAIN = false, HAS_PRE = false;
    const float* base; float* out; int ldc; bf16_t* xb; float* ssq;
    __device__ __forceinline__ void operator()(const f32x4 (&acc)[2][2][4][2], const Unit& u, int wr, int wc, int fr, int fq, const PG8_LAS float*) const {
        const int row0 = u.pm * BM + wr * 64 + fr; const int col0 = u.pn * BM + wc * 32 + 8 * fq;
#pragma unroll
        for (int ai = 0; ai < 2; ++ai)
#pragma unroll
            for (int m = 0; m < 4; ++m) { const int row = row0 + ai * HALF + m * 16; const size_t off = (size_t)row * ldc + col0; float ss = 0.f;
#pragma unroll
                for (int bj = 0; bj < 2; ++bj) {
                    const f32x4 b0 = *(const f32x4*)(base + off + bj * HALF), b1 = *(const f32x4*)(base + off + bj * HALF + 4);
                    const f32x4 v0 = b0 + acc[ai][bj][m][0], v1 = b1 + acc[ai][bj][m][1];
                    *(f32x4*)(out + off + bj * HALF) = v0; *(f32x4*)(out + off + bj * HALF + 4) = v1;
                    if (xb) { u32x4 w; w.x = cvt_pk_bf16(v0[0], v0[1]); w.y = cvt_pk_bf16(v0[2], v0[3]); w.z = cvt_pk_bf16(v1[0], v1[1]); w.w = cvt_pk_bf16(v1[2], v1[3]);
                        *(u32x4*)(xb + off + bj * HALF) = w;
                        ss += ((v0[0] * v0[0] + v0[1] * v0[1]) + (v0[2] * v0[2] + v0[3] * v0[3])) + ((v1[0] * v1[0] + v1[1] * v1[1]) + (v1[2] * v1[2] + v1[3] * v1[3])); } }
                if (xb) { ss += __shfl_xor(ss, 16); ss += __shfl_xor(ss, 32); if (fq == 0) ssq[(size_t)row * 16 + u.pn * 4 + wc] = ss; } }
    }
};

template <class Epi, class Sched, bool ALIGN_EPI = false, bool SP2 = false>
__device__ __forceinline__ void gemm_phase(PG8_LAS unsigned char* lds, const Gemm g, const Sched& S, const Epi& E) {
    int tid_ = threadIdx.x; asm volatile("" : "+v"(tid_));
    const int tid = tid_, wid = __builtin_amdgcn_readfirstlane(tid >> 6), lane = tid & 63, wr = wid >> 2, wc = wid & 3, fr = lane & 15, fq = lane >> 4;
    const int K = g.K, nt = K / BK;
    unsigned voffA[2], voffB[2];
#pragma unroll
    for (int i = 0; i < 2; ++i) { int R, C; stage_rc(tid * 16 + i * 8192, R, C); const int Rb = Epi::PERM ? ((R & ~31) + perm32(R & 31)) : R;
        voffA[i] = (unsigned)(R * K + C) * 2u; voffB[i] = (unsigned)(Rb * K + C) * 2u; }
    const size_t kstep = (size_t)(BK * 2);
    const size_t hstep = (size_t)HALF * K * 2;
    const size_t tstep = 2 * hstep;
    const unsigned ldsw = (unsigned)wid * 1024u;
    const int aoff = lds_byte(wr * 64 + fr, fq * 8), boff = lds_byte(wc * 32 + fr, fq * 8);
#define PG8_SA(b, h) (((b) * 2 + (h)) * HTB)
#define PG8_SB(b, h) ((4 + (b) * 2 + (h)) * HTB)
#define PG8_STAGE(bufoff, gbase, voff) do { _Pragma("unroll") for (int _i = 0; _i < 2; ++_i) \
        __builtin_amdgcn_global_load_lds((const unsigned*)((const char*)(gbase) + (voff)[_i]), (PG8_LAS unsigned*)(lds + (bufoff) + ldsw + _i * 8192), 16, 0, 0); } while (0)
#define PG8_LDA(dst, b, h) do { _Pragma("unroll") for (int m = 0; m < 4; ++m) _Pragma("unroll") for (int k = 0; k < 2; ++k) dst[m][k] = *(const PG8_LAS bf16x8*)(lds + PG8_SA(b, h) + aoff + m * 2048 + k * 1024); } while (0)
#define PG8_LDB(dst, b, h) do { _Pragma("unroll") for (int n = 0; n < 2; ++n) _Pragma("unroll") for (int k = 0; k < 2; ++k) dst[n][k] = *(const PG8_LAS bf16x8*)(lds + PG8_SB(b, h) + boff + n * 2048 + k * 1024); } while (0)
#define PG8_MMA(ai, bj, At, Bt) do { __builtin_amdgcn_s_setprio(1); _Pragma("unroll") for (int m = 0; m < 4; ++m) _Pragma("unroll") for (int n = 0; n < 2; ++n) _Pragma("unroll") for (int k = 0; k < 2; ++k) \
        acc[ai][bj][m][n] = __builtin_amdgcn_mfma_f32_16x16x32_bf16(Bt[n][k], At[m][k], acc[ai][bj][m][n], 0, 0, 0); __builtin_amdgcn_s_setprio(0); } while (0)
#define PG8_WAIT_V(n) asm volatile("s_waitcnt vmcnt(" #n ")" ::: "memory")
#define PG8_WAIT_L(n) asm volatile("s_waitcnt lgkmcnt(" #n ")" ::: "memory")
#define PG8_BAR __builtin_amdgcn_s_barrier()
#define PG8_SCHED __builtin_amdgcn_sched_barrier(0)
    Unit cur, nxt; int ui = 0;
    if (!S.next(0, cur)) return;
    f32x4 acc[2][2][4][2];
#pragma unroll
    for (int a = 0; a < 2; ++a)
#pragma unroll
        for (int b = 0; b < 2; ++b)
#pragma unroll
            for (int m = 0; m < 4; ++m)
#pragma unroll
                for (int n = 0; n < 2; ++n) acc[a][b][m][n] = (f32x4){0.f, 0.f, 0.f, 0.f};
    bf16x8 At[4][2], B0[2][2], B1[2][2];
    const char* cA = (const char*)g.A + (size_t)cur.pm * tstep; const char* cB = (const char*)g.Bt + (size_t)cur.pn * tstep;
    S.a_ready(cur);
    PG8_LAS float* ptab = (PG8_LAS float*)(lds + STAGE_BYTES);
    if constexpr (Epi::HAS_PRE) { const auto p0 = E.pre_load(cur.pm, tid); E.pre_store(p0, ptab, tid); }
    if constexpr (SP2) {
        PG8_STAGE(PG8_SB(0, 0), cB, voffB); PG8_STAGE(PG8_SB(0, 1), cB + hstep, voffB); PG8_STAGE(PG8_SA(0, 0), cA, voffA); PG8_STAGE(PG8_SA(0, 1), cA + hstep, voffA);
        if (wr == 1) PG8_BAR;
        PG8_WAIT_V(2); PG8_BAR;
        PG8_STAGE(PG8_SB(1, 0), cB + kstep, voffB); PG8_STAGE(PG8_SA(1, 0), cA + kstep, voffA); PG8_STAGE(PG8_SB(1, 1), cB + hstep + kstep, voffB);
        PG8_WAIT_V(6); PG8_BAR;
    } else {
        PG8_STAGE(PG8_SB(0, 0), cB, voffB); PG8_STAGE(PG8_SA(0, 0), cA, voffA); PG8_STAGE(PG8_SB(0, 1), cB + hstep, voffB); PG8_STAGE(PG8_SA(0, 1), cA + hstep, voffA);
        if (wr == 1) PG8_BAR;
        PG8_WAIT_V(4); PG8_BAR;
        PG8_STAGE(PG8_SB(1, 0), cB + kstep, voffB); PG8_STAGE(PG8_SA(1, 0), cA + kstep, voffA); PG8_STAGE(PG8_SB(1, 1), cB + hstep + kstep, voffB);
        PG8_WAIT_V(6); PG8_BAR;
    }
    for (;;) {
        const bool has_next = S.next(ui + 1, nxt);
        const char* nA = has_next ? (const char*)g.A + (size_t)nxt.pm * tstep : cA; const char* nB = has_next ? (const char*)g.Bt + (size_t)nxt.pn * tstep : cB;
        for (int t = 0; t < nt; t += 2) {
            const bool last = (t == nt - 2);
            const char* a1 = cA + (size_t)(t + 1) * kstep;
            const char* a2 = last ? nA : cA + (size_t)(t + 2) * kstep; const char* b2 = last ? nB : cB + (size_t)(t + 2) * kstep;
            const char* a3 = a2 + kstep; const char* b3 = b2 + kstep;
            if (last && has_next) S.a_ready(nxt);
            if constexpr (SP2) {
            PG8_LDB(B0, 0, 0); PG8_LDB(B1, 0, 1); PG8_SCHED; PG8_LDA(At, 0, 0); PG8_STAGE(PG8_SA(1, 1), a1 + hstep, voffA);
            PG8_WAIT_V(8); PG8_WAIT_L(0); PG8_BAR; PG8_MMA(0, 0, At, B0); PG8_MMA(0, 1, At, B1); PG8_BAR; PG8_SCHED;
            PG8_LDA(At, 0, 1); PG8_STAGE(PG8_SB(0, 0), b2, voffB); PG8_STAGE(PG8_SB(0, 1), b2 + hstep, voffB); PG8_STAGE(PG8_SA(0, 0), a2, voffA);
            PG8_WAIT_V(8); PG8_WAIT_L(0); PG8_BAR; PG8_MMA(1, 0, At, B0); PG8_MMA(1, 1, At, B1); PG8_BAR; PG8_SCHED;
            PG8_LDB(B0, 1, 0); PG8_LDB(B1, 1, 1); PG8_SCHED; PG8_LDA(At, 1, 0); PG8_STAGE(PG8_SA(0, 1), a2 + hstep, voffA);
            PG8_WAIT_V(8); PG8_WAIT_L(0); PG8_BAR; PG8_MMA(0, 0, At, B0); PG8_MMA(0, 1, At, B1); PG8_BAR; PG8_SCHED;
            PG8_LDA(At, 1, 1); PG8_STAGE(PG8_SB(1, 0), b3, voffB); PG8_STAGE(PG8_SB(1, 1), b3 + hstep, voffB); PG8_STAGE(PG8_SA(1, 0), a3, voffA);
            PG8_WAIT_V(8); PG8_WAIT_L(0); PG8_BAR; PG8_MMA(1, 0, At, B0); PG8_MMA(1, 1, At, B1); PG8_BAR; PG8_SCHED;
            } else {
            PG8_LDB(B0, 0, 0); PG8_SCHED; PG8_LDA(At, 0, 0); PG8_STAGE(PG8_SA(1, 1), a1 + hstep, voffA);
            PG8_WAIT_L(8); PG8_BAR; PG8_WAIT_L(0); PG8_MMA(0, 0, At, B0); PG8_BAR; PG8_SCHED;
            PG8_LDB(B1, 0, 1); PG8_STAGE(PG8_SB(0, 0), b2, voffB);
            PG8_BAR; PG8_WAIT_L(0); PG8_MMA(0, 1, At, B1); PG8_BAR;
            PG8_LDA(At, 0, 1); PG8_STAGE(PG8_SA(0, 0), a2, voffA);
            PG8_BAR; PG8_WAIT_L(0); PG8_MMA(1, 0, At, B0); PG8_BAR; PG8_SCHED;
            PG8_STAGE(PG8_SB(0, 1), b2 + hstep, voffB);
            PG8_WAIT_V(6); PG8_BAR; PG8_MMA(1, 1, At, B1); PG8_BAR;
            PG8_LDB(B0, 1, 0); PG8_SCHED; PG8_LDA(At, 1, 0); PG8_STAGE(PG8_SA(0, 1), a2 + hstep, voffA);
            PG8_WAIT_L(8); PG8_BAR; PG8_WAIT_L(0); PG8_MMA(0, 0, At, B0); PG8_BAR; PG8_SCHED;
            PG8_LDB(B1, 1, 1); PG8_STAGE(PG8_SB(1, 0), b3, voffB);
            PG8_BAR; PG8_WAIT_L(0); PG8_MMA(0, 1, At, B1); PG8_BAR;
            PG8_LDA(At, 1, 1); PG8_STAGE(PG8_SA(1, 0), a3, voffA);
            PG8_BAR; PG8_WAIT_L(0); PG8_MMA(1, 0, At, B0); PG8_BAR; PG8_SCHED;
            PG8_STAGE(PG8_SB(1, 1), b3 + hstep, voffB);
            PG8_WAIT_V(6); PG8_BAR; PG8_MMA(1, 1, At, B1); PG8_BAR;
            }
        }
        if constexpr (ALIGN_EPI) { if (wr == 0) PG8_BAR; }
        if constexpr (Epi::HAS_PRE) {
            if (has_next) { const auto pn_ = E.pre_load(nxt.pm, tid); E(acc, cur, wr, wc, fr, fq, ptab + (ui & 1) * 256); E.pre_store(pn_, ptab + ((ui + 1) & 1) * 256, tid); }
            else E(acc, cur, wr, wc, fr, fq, ptab + (ui & 1) * 256);
        } else { E(acc, cur, wr, wc, fr, fq, ptab); }
        S.done(cur);
        if (!has_next) break;
#pragma unroll
        for (int a = 0; a < 2; ++a)
#pragma unroll
            for (int b = 0; b < 2; ++b)
#pragma unroll
                for (int m = 0; m < 4; ++m)
#pragma unroll
                    for (int n = 0; n < 2; ++n) acc[a][b][m][n] = (f32x4){0.f, 0.f, 0.f, 0.f};
        cur = nxt; cA = nA; cB = nB; ++ui;
        if constexpr (ALIGN_EPI) { if (wr == 1) PG8_BAR; }
    }
    PG8_WAIT_V(0);
    if constexpr (!ALIGN_EPI) { if (wr == 0) PG8_BAR; }
    PG8_BAR;
#undef PG8_SA
#undef PG8_SB
#undef PG8_STAGE
#undef PG8_LDA
#undef PG8_LDB
#undef PG8_MMA
#undef PG8_WAIT_V
#undef PG8_WAIT_L
#undef PG8_BAR
#undef PG8_SCHED
}
}

#ifndef PROBE
#define PROBE 0
#endif
constexpr int NB = 32, SEQ = 2048, DM = 1024, MTOK = NB * SEQ, INW = 3096, ZW = 3328, FF = 4096, DEPTH = 2;
constexpr int ZC_RQ = 0, ZC_RK = 256, ZC_RV = 512, ZC_RG = 768, ZC_CB = 1024, ZC_CC = 1280, ZC_CH = 1536, ZC_NQ = 1792,
              ZC_KC = 2304, ZC_VC = 2432, ZC_KS = 2560, ZC_VS = 2688, ZC_KW = 2816, ZC_VW = 2944, ZC_NG = 3072;
constexpr float EPS = 1e-6f, LOG2E = 1.4426950408889634f;
constexpr size_t MiB = 1u << 20;
constexpr size_t WS_WIN = 1 * MiB, WS_WOUT = 14 * MiB, WS_WUP = 18 * MiB, WS_WDN = 34 * MiB, WS_CS = 50 * MiB, WS_KCMP = 51 * MiB, WS_VCMP = 52 * MiB,
                 WS_KSN = 53 * MiB, WS_KWN = 69 * MiB, WS_SSQ = 86 * MiB, WS_W1T = 90 * MiB, WS_CB = 91 * MiB, WS_XN = 96 * MiB, WS_Z = 224 * MiB, WS_H = 224 * MiB, WS_MIX = 736 * MiB, WS_END = 896 * MiB;
constexpr int LDS_BYTES = 139264;
constexpr int NWAVES = 8, NTHREADS = 512;

struct KArgs { const float* in[16]; float* out; unsigned char* ws; int ph_lo, ph_hi; };
enum { I_X = 0, I_NORM_MIX, I_W_IN, I_CONV_W, I_QN, I_KN, I_PEK, I_W1K, I_W2K, I_PEV, I_W1V, I_W2V, I_W_OUT, I_NORM_MLP, I_W_UP, I_W_DOWN };

__device__ __forceinline__ float bf2f(unsigned short u) { return __uint_as_float((unsigned)u << 16); }
__device__ __forceinline__ unsigned f2bf(float f) { unsigned u = __float_as_uint(f); return (u + 0x7fffu + ((u >> 16) & 1u)) >> 16; }
__device__ __forceinline__ unsigned pk2(float lo, float hi) { return f2bf(lo) | (f2bf(hi) << 16); }
__device__ __forceinline__ float wave_sum(float v) {
#pragma unroll
    for (int o = 1; o < 64; o <<= 1) v += __shfl_xor(v, o);
    return v;
}
__device__ __forceinline__ float wave_max(float v) {
#pragma unroll
    for (int o = 1; o < 64; o <<= 1) v = fmaxf(v, __shfl_xor(v, o));
    return v;
}
#define LDS_FENCE() asm volatile("s_waitcnt lgkmcnt(0)" ::: "memory")

__device__ __forceinline__ void transpose_item(const float* W, int K, int N, int Npad, bf16_t* WT, LAS float* scr, int item, int lane, const float* gain) {
    const int nblk = Npad / 32, kb = item / nblk, nb = item % nblk, k0 = 64 * kb, n0 = 32 * nb;
#pragma unroll
    for (int i = 0; i < 8; ++i) { const int q = i * 64 + lane, kk = q >> 3, c4 = (q & 7) * 4; const int n = n0 + c4;
        f32x4 v = (f32x4){0.f, 0.f, 0.f, 0.f};
        if (n < N) v = *(const f32x4*)(W + (size_t)(k0 + kk) * N + n);
        const float gsc = gain ? gain[k0 + kk] : 1.f;
        scr[kk * 33 + c4] = v[0] * gsc; scr[kk * 33 + c4 + 1] = v[1] * gsc; scr[kk * 33 + c4 + 2] = v[2] * gsc; scr[kk * 33 + c4 + 3] = v[3] * gsc; }
    LDS_FENCE();
    const int c = lane & 7;
#pragma unroll
    for (int j = 0; j < 4; ++j) { const int nn = (lane >> 3) + 8 * j; const LAS float* s = scr + (8 * c) * 33 + nn;
        u32x4 o; o.x = pk2(s[0 * 33], s[1 * 33]); o.y = pk2(s[2 * 33], s[3 * 33]); o.z = pk2(s[4 * 33], s[5 * 33]); o.w = pk2(s[6 * 33], s[7 * 33]);
        *(u32x4*)(WT + (size_t)(n0 + nn) * K + k0 + 8 * c) = o; }
    LDS_FENCE();
}

__device__ __forceinline__ void phase_prologue(const KArgs& a, LAS unsigned char* lds, int wave, int lane) {
    LAS float* scr = (LAS float*)(lds + wave * 16384);
    const int gw = blockIdx.x * NWAVES + wave, NGW = gridDim.x * NWAVES;
    constexpr int I_IN = (DM / 64) * (ZW / 32), I_OUT = (DM / 64) * (DM / 32), I_UP = (DM / 64) * (FF / 32), I_DN = (FF / 64) * (DM / 32);
    constexpr int PER_L = I_IN + I_OUT + I_UP + I_DN;
    for (int it = gw; it < DEPTH * PER_L; it += NGW) {
        const int l = it / PER_L; int r = it % PER_L;
        if (r < I_IN) { transpose_item(a.in[I_W_IN] + (size_t)l * DM * INW, DM, INW, ZW, (bf16_t*)(a.ws + WS_WIN) + (size_t)l * ZW * DM, scr, r, lane, a.in[I_NORM_MIX] + l * DM); continue; } r -= I_IN;
        if (r < I_OUT) { transpose_item(a.in[I_W_OUT] + (size_t)l * DM * DM, DM, DM, DM, (bf16_t*)(a.ws + WS_WOUT) + (size_t)l * DM * DM, scr, r, lane, nullptr); continue; } r -= I_OUT;
        if (r < I_UP) { transpose_item(a.in[I_W_UP] + (size_t)l * DM * FF, DM, FF, FF, (bf16_t*)(a.ws + WS_WUP) + (size_t)l * FF * DM, scr, r, lane, a.in[I_NORM_MLP] + l * DM); continue; } r -= I_UP;
        transpose_item(a.in[I_W_DOWN] + (size_t)l * FF * DM, FF, DM, DM, (bf16_t*)(a.ws + WS_WDN) + (size_t)l * DM * FF, scr, r, lane, nullptr);
    }
    for (int e = blockIdx.x * NTHREADS + threadIdx.x; e < DEPTH * 2 * 2048 * 8; e += gridDim.x * NTHREADS) {
        const int c8 = e & 7, ksrc = (e >> 3) & 2047, lk = e >> 14, l = lk >> 1, kv = lk & 1;
        const float* src = a.in[kv ? I_W1V : I_W1K] + ((size_t)l * 2048 + ksrc) * 64 + c8 * 8;
        const f32x4 v0 = *(const f32x4*)src, v1 = *(const f32x4*)(src + 4);
        const int lpos = ksrc >> 6, d = ksrc & 63, a2 = lpos >> 4, lp = lpos & 15;
        bf16_t* dst = (bf16_t*)(a.ws + WS_W1T) + ((size_t)lk * 128 + a2 * 64 + c8 * 8) * 1024 + lp * 64 + d;
#pragma unroll
        for (int i = 0; i < 4; ++i) { dst[(size_t)i * 1024] = (bf16_t)f2bf(v0[i]); dst[(size_t)(4 + i) * 1024] = (bf16_t)f2bf(v1[i]); }
    }
    if (blockIdx.x < 4) {
        const int lk = blockIdx.x, l = lk >> 1, kv = lk & 1, j = lane;
        const float* pe = a.in[kv ? I_PEV : I_PEK] + (size_t)l * 2048; const float* w1 = a.in[kv ? I_W1V : I_W1K] + (size_t)l * 2048 * 64;
        float s = 0.f;
        for (int k = wave * 256; k < wave * 256 + 256; ++k) s += pe[k] * w1[(size_t)k * 64 + j];
        LAS float* red = (LAS float*)(lds + 131072);
        red[wave * 64 + lane] = s;
        __syncthreads();
        if (wave == 0) { float t = 0.f;
#pragma unroll
            for (int w = 0; w < 8; ++w) t += red[w * 64 + lane];
            ((float*)(a.ws + WS_CB))[lk * 64 + j] = t; }
    }
    float2* cs = (float2*)(a.ws + WS_CS);
    for (int e = blockIdx.x * NTHREADS + threadIdx.x; e < SEQ * 32; e += gridDim.x * NTHREADS) {
        const int pos = e >> 5, i = e & 31;
        const float inv_freq = exp2f(-(float)i * 0.42863588321127255f);
        const float ang = (float)pos * inv_freq;
        const double rev = (double)ang * 0.15915494309189535;
        const float fr = (float)(rev - floor(rev));
        cs[e] = make_float2(__builtin_amdgcn_cosf(fr), __builtin_amdgcn_sinf(fr));
    }
}

__device__ __forceinline__ void phase_norm(const float* x, const float* gain, bf16_t* xn, float* rs, int wave, int lane) {
    const int gw = blockIdx.x * NWAVES + wave, NGW = gridDim.x * NWAVES;
    f32x4 gv[4];
#pragma unroll
    for (int j = 0; j < 4; ++j) gv[j] = *((const f32x4*)gain + 64 * j + lane);
    for (int m = gw; m < MTOK; m += NGW) {
        const f32x4* xr = (const f32x4*)(x + (size_t)m * DM) + lane;
        f32x4 v[4]; float s = 0.f;
#pragma unroll
        for (int j = 0; j < 4; ++j) { v[j] = xr[64 * j]; s += (v[j].x * v[j].x + v[j].y * v[j].y) + (v[j].z * v[j].z + v[j].w * v[j].w); }
        const float rstd = rsqrtf(wave_sum(s) * (1.f / DM) + EPS);
        float hm = 0.f;
#pragma unroll
        for (int j = 0; j < 4; ++j) { v[j] = v[j] * rstd * gv[j]; hm = fmaxf(hm, fmaxf(fmaxf(fabsf(v[j].x), fabsf(v[j].y)), fmaxf(fabsf(v[j].z), fabsf(v[j].w)))); }
        hm = wave_max(hm);
        const float sc = (hm > 0.f) ? bf2f((unsigned short)f2bf(hm)) / hm : 1.f;
        u32x2* o8 = (u32x2*)(xn + (size_t)m * DM) + lane;
#pragma unroll
        for (int j = 0; j < 4; ++j) { u32x2 w; w.x = pk2(v[j].x * sc, v[j].y * sc); w.y = pk2(v[j].z * sc, v[j].w * sc); o8[64 * j] = w; }
        if (lane == 0) rs[m] = 1.f / sc;
    }
}

__device__ __forceinline__ void phase_xcvt(const float* x, bf16_t* xb, float* ssq, int wave, int lane) {
    const int gw = blockIdx.x * NWAVES + wave, NGW = gridDim.x * NWAVES;
    for (int m = gw; m < MTOK; m += NGW) {
        const f32x4* xr = (const f32x4*)(x + (size_t)m * DM) + lane;
        f32x4 v[4]; float s = 0.f;
#pragma unroll
        for (int j = 0; j < 4; ++j) { v[j] = xr[64 * j]; s += (v[j].x * v[j].x + v[j].y * v[j].y) + (v[j].z * v[j].z + v[j].w * v[j].w); }
        s = wave_sum(s);
        u32x2* o8 = (u32x2*)(xb + (size_t)m * DM) + lane;
#pragma unroll
        for (int j = 0; j < 4; ++j) { u32x2 w; w.x = pk2(v[j].x, v[j].y); w.y = pk2(v[j].z, v[j].w); o8[64 * j] = w; }
        if (lane < 16) ssq[(size_t)m * 16 + lane] = (lane == 0) ? s : 0.f;
    }
}

__device__ __forceinline__ void ret_item(const KArgs& a, int l, int bh, LAS unsigned char* lds, int wave, int lane) {
    int tid = threadIdx.x; asm volatile("" : "+v"(tid));
    const int b = bh >> 2, h = bh & 3;
    const float gamma = 1.0f - exp2f(-5.0f - (float)h);
    const bf16_t* Z = (const bf16_t*)(a.ws + WS_Z);
    bf16_t* MIX = (bf16_t*)(a.ws + WS_MIX);
    const float2* cs = (const float2*)(a.ws + WS_CS);
    LAS float* qs = (LAS float*)lds; LAS float* ks = qs + 32 * 64; LAS float* vs = ks + 32 * 64; LAS float* op = vs + 32 * 64;
    float S[8];
#pragma unroll
    for (int i = 0; i < 8; ++i) S[i] = 0.f;
    for (int tb = 0; tb < SEQ / 32; ++tb) {
#pragma unroll
        for (int r = 0; r < 2; ++r) {
            const int p = tid + r * NTHREADS, tt = p >> 5, i = p & 31, pos = tb * 32 + tt;
            const bf16_t* zr = Z + (size_t)(b * SEQ + pos) * ZW + h * 64 + 2 * i;
            const unsigned qq = *(const unsigned*)(zr + ZC_RQ), kk = *(const unsigned*)(zr + ZC_RK), vv = *(const unsigned*)(zr + ZC_RV);
            const float2 c = cs[pos * 32 + i];
            const float q0 = bf2f(qq & 0xffff), q1 = bf2f(qq >> 16), k0 = bf2f(kk & 0xffff), k1 = bf2f(kk >> 16);
            qs[tt * 64 + 2 * i] = q0 * c.x - q1 * c.y; qs[tt * 64 + 2 * i + 1] = q1 * c.x + q0 * c.y;
            ks[tt * 64 + 2 * i] = (k0 * c.x - k1 * c.y) * 0.125f; ks[tt * 64 + 2 * i + 1] = (k1 * c.x + k0 * c.y) * 0.125f;
            vs[tt * 64 + 2 * i] = bf2f(vv & 0xffff); vs[tt * 64 + 2 * i + 1] = bf2f(vv >> 16);
        }
        __syncthreads();
        for (int tt = 0; tt < 32; ++tt) {
            const f32x4 ka = *(const LAS f32x4*)(ks + tt * 64 + wave * 8), kb = *(const LAS f32x4*)(ks + tt * 64 + wave * 8 + 4);
            const f32x4 qa = *(const LAS f32x4*)(qs + tt * 64 + wave * 8), qb = *(const LAS f32x4*)(qs + tt * 64 + wave * 8 + 4);
            const float v = vs[tt * 64 + lane];
            float po = 0.f;
#pragma unroll
            for (int i = 0; i < 4; ++i) { S[i] = gamma * S[i] + ka[i] * v; po += qa[i] * S[i]; S[4 + i] = gamma * S[4 + i] + kb[i] * v; po += qb[i] * S[4 + i]; }
            op[(tt * 8 + wave) * 64 + lane] = po;
        }
        __syncthreads();
#pragma unroll
        for (int r = 0; r < 4; ++r) {
            const int tt = wave + 8 * r, pos = tb * 32 + tt;
            float o = 0.f;
#pragma unroll
            for (int w = 0; w < 8; ++w) o += op[(tt * 8 + w) * 64 + lane];
            const float rstd = rsqrtf(wave_sum(o * o) * (1.f / 64.f) + EPS);
            const size_t row = (size_t)(b * SEQ + pos);
            const float g = bf2f(Z[row * ZW + ZC_RG + h * 64 + lane]);
            const float sg = g / (1.f + __expf(-g));
            MIX[row * DM + h * 64 + lane] = (bf16_t)f2bf(sg * o * rstd);
        }
        __syncthreads();
    }
}

__device__ __forceinline__ void conv_item(const KArgs& a, int l, int item) {
    const bf16_t* Z = (const bf16_t*)(a.ws + WS_Z);
    bf16_t* MIX = (bf16_t*)(a.ws + WS_MIX);
    const float* cw = a.in[I_CONV_W] + (size_t)l * 3 * 256;
    int tid = threadIdx.x; asm volatile("" : "+v"(tid));
    const int cg8 = (tid & 31) * 8;
    float w0[8], w1[8], w2[8];
#pragma unroll
    for (int i = 0; i < 8; ++i) { w0[i] = cw[cg8 + i]; w1[i] = cw[256 + cg8 + i]; w2[i] = cw[512 + cg8 + i]; }
    const int rbase = item * 256 + (tid >> 5) * 16;
    for (int q = 0; q < 4; ++q) {
        const int r0 = rbase + 4 * q, s0 = r0 & (SEQ - 1);
        u32x4 cc[6], hh[6], bb[4];
#pragma unroll
        for (int i = 0; i < 6; ++i) { const int rr = (s0 == 0 && i < 2) ? r0 : r0 - 2 + i; const bf16_t* zr = Z + (size_t)rr * ZW + cg8; cc[i] = *(const u32x4*)(zr + ZC_CC); hh[i] = *(const u32x4*)(zr + ZC_CH); }
#pragma unroll
        for (int i = 0; i < 4; ++i) bb[i] = *(const u32x4*)(Z + (size_t)(r0 + i) * ZW + ZC_CB + cg8);
        float u[6][8];
#pragma unroll
        for (int i = 0; i < 6; ++i) { const float z = (s0 == 0 && i < 2) ? 0.f : 1.f;
#pragma unroll
            for (int j = 0; j < 4; ++j) { u[i][2 * j] = z * bf2f(cc[i][j] & 0xffff) * bf2f(hh[i][j] & 0xffff); u[i][2 * j + 1] = z * bf2f(cc[i][j] >> 16) * bf2f(hh[i][j] >> 16); } }
#pragma unroll
        for (int i = 0; i < 4; ++i) { u32x4 o;
#pragma unroll
            for (int j = 0; j < 4; ++j) {
                const float y0 = w0[2 * j] * u[i][2 * j] + w1[2 * j] * u[i + 1][2 * j] + w2[2 * j] * u[i + 2][2 * j];
                const float y1 = w0[2 * j + 1] * u[i][2 * j + 1] + w1[2 * j + 1] * u[i + 1][2 * j + 1] + w2[2 * j + 1] * u[i + 2][2 * j + 1];
                o[j] = pk2(bf2f(bb[i][j] & 0xffff) * y0, bf2f(bb[i][j] >> 16) * y1); }
            *(u32x4*)(MIX + (size_t)(r0 + i) * DM + 256 + cg8) = o; }
    }
}

__device__ __forceinline__ void knorm_item(const KArgs& a, int l, int item, int wave, int lane) {
    const bf16_t* Z = (const bf16_t*)(a.ws + WS_Z);
    const float kg = a.in[I_KN][l * 64 + lane];
    for (int r0 = 0; r0 < 128; r0 += 16) {
        float v[16];
#pragma unroll
        for (int i = 0; i < 16; ++i) { const int task = item * 1024 + wave * 128 + r0 + i, row = task >> 2, which = (task >> 1) & 1, g = task & 1;
            v[i] = bf2f(Z[(size_t)row * ZW + (which ? ZC_KW : ZC_KS) + g * 64 + lane]); }
#pragma unroll
        for (int i = 0; i < 16; ++i) { const int task = item * 1024 + wave * 128 + r0 + i, row = task >> 2, which = (task >> 1) & 1, g = task & 1;
            const float rstd = rsqrtf(wave_sum(v[i] * v[i]) * (1.f / 64.f) + EPS);
            bf16_t* dst = (bf16_t*)(a.ws + (which ? WS_KWN : WS_KSN));
            dst[(size_t)row * 128 + g * 64 + lane] = (bf16_t)f2bf(v[i] * rstd * kg); }
    }
}

__device__ __forceinline__ void cmp_item(const KArgs& a, int l, int item, LAS unsigned char* lds, int wave, int lane) {
    int tid = threadIdx.x; asm volatile("" : "+v"(tid));
    const int nc = item & 7, kv = (item >> 3) & 1, g = (item >> 4) & 1, b = item >> 5;
    const bf16_t* Z = (const bf16_t*)(a.ws + WS_Z);
    const float* pe = a.in[kv ? I_PEV : I_PEK] + (size_t)l * 2048;
    const float* w1 = a.in[kv ? I_W1V : I_W1K] + (size_t)l * 2048 * 64;
    const float* w2 = a.in[kv ? I_W2V : I_W2K] + (size_t)l * 64 * 64;
    LAS float* xs = (LAS float*)lds;
    LAS float* red = xs + 272 * 64;
    LAS float* o1 = red + 8 * 16 * 64;
    const int t0 = nc * 256, zc = (kv ? ZC_VC : ZC_KC) + g * 64;
    for (int e = tid; e < 272 * 8; e += NTHREADS) {
        const int tt = e >> 3, c8 = (e & 7) * 8, tok = t0 + tt;
        u32x4 v = (u32x4){0u, 0u, 0u, 0u};
        if (tok < SEQ) v = *(const u32x4*)(Z + (size_t)(b * SEQ + tok) * ZW + zc + c8);
#pragma unroll
        for (int i = 0; i < 4; ++i) { xs[tt * 64 + c8 + 2 * i] = bf2f(v[i] & 0xffff); xs[tt * 64 + c8 + 2 * i + 1] = bf2f(v[i] >> 16); }
    }
    __syncthreads();
    float acc[16]; float accb = 0.f;
#pragma unroll
    for (int i = 0; i < 16; ++i) acc[i] = 0.f;
    for (int kk = 0; kk < 256; ++kk) {
        const int k = wave * 256 + kk, lpos = k >> 6, d = k & 63;
        const float w = w1[(size_t)k * 64 + lane];
        accb += pe[k] * w;
#pragma unroll
        for (int nb = 0; nb < 16; ++nb) acc[nb] += xs[(16 * nb + lpos) * 64 + d] * w;
    }
#pragma unroll
    for (int nb = 0; nb < 16; ++nb) red[(wave * 16 + nb) * 64 + lane] = acc[nb] + accb;
    __syncthreads();
    for (int e = tid; e < 16 * 64; e += NTHREADS) {
        float s = 0.f;
#pragma unroll
        for (int w = 0; w < 8; ++w) s += red[w * 16 * 64 + e];
        o1[e] = s / (1.f + __expf(-s));
    }
    __syncthreads();
    const float kg = a.in[I_KN][l * 64 + lane];
    bf16_t* dst = (bf16_t*)(a.ws + (kv ? WS_VCMP : WS_KCMP)) + (size_t)((b * 2 + g) * 128) * 64;
#pragma unroll
    for (int r = 0; r < 2; ++r) {
        const int nb = wave + 8 * r, n = nc * 16 + nb;
        float s = 0.f;
        for (int j = 0; j < 64; ++j) s += o1[nb * 64 + j] * w2[j * 64 + lane];
        if (!kv) { const float rstd = rsqrtf(wave_sum(s * s) * (1.f / 64.f) + EPS); s = s * rstd * kg; }
        if (n >= 127) s = 0.f;
        dst[(size_t)n * 64 + lane] = (bf16_t)f2bf(s);
    }
    __syncthreads();
}

__device__ __forceinline__ f32x4 dot4(const bf16_t* krow, const LAS float* qs) {
    float a0 = 0.f, a1 = 0.f, a2 = 0.f, a3 = 0.f;
#pragma unroll 1
    for (int c = 0; c < 8; ++c) {
        const u32x4 kv = *(const u32x4*)(krow + c * 8);
        float k[8];
#pragma unroll
        for (int i = 0; i < 4; ++i) { k[2 * i] = bf2f(kv[i] & 0xffff); k[2 * i + 1] = bf2f(kv[i] >> 16); }
#pragma unroll
        for (int h = 0; h < 4; ++h) {
            const f32x4 q0 = *(const LAS f32x4*)(qs + h * 64 + c * 8), q1 = *(const LAS f32x4*)(qs + h * 64 + c * 8 + 4);
            const float s = k[0] * q0[0] + k[1] * q0[1] + k[2] * q0[2] + k[3] * q0[3] + k[4] * q1[0] + k[5] * q1[1] + k[6] * q1[2] + k[7] * q1[3];
            if (h == 0) a0 += s; else if (h == 1) a1 += s; else if (h == 2) a2 += s; else a3 += s;
        }
    }
    return (f32x4){a0, a1, a2, a3};
}
__device__ __forceinline__ void blk_step(const f32x4 s, bool valid, const bf16_t* vbase, size_t vstride, int nk, LAS f32x4* pbuf, int lane, f32x4& m, f32x4& ls, f32x4& o) {
    f32x4 p;
#pragma unroll
    for (int h = 0; h < 4; ++h) {
        const float sm = valid ? s[h] : -1e30f;
        const float mn = fmaxf(m[h], wave_max(sm));
        const float sc = exp2f(m[h] - mn);
        p[h] = valid ? exp2f(s[h] - mn) : 0.f;
        ls[h] = ls[h] * sc + p[h]; o[h] *= sc; m[h] = mn;
    }
    LDS_FENCE();
    pbuf[lane] = p;
    LDS_FENCE();
    for (int key = 0; key < nk; ++key) {
        const f32x4 pp = pbuf[key];
        const float v = bf2f(vbase[(size_t)key * vstride + lane]);
        o[0] += pp[0] * v; o[1] += pp[1] * v; o[2] += pp[2] * v; o[3] += pp[3] * v;
    }
    LDS_FENCE();
}

__device__ __forceinline__ void nsa_task(const KArgs& a, int l, int b, int g, int t, LAS float* qs, LAS f32x4* pbuf, int lane_in) {
    int lane = lane_in; asm volatile("" : "+v"(lane));
    const bf16_t* Z = (const bf16_t*)(a.ws + WS_Z);
    const size_t row = (size_t)b * SEQ + t;
    const bf16_t* zrow = Z + row * ZW;
    {
        const int h = lane >> 4, dq = (lane & 15) * 4;
        const u32x2 qq = *(const u32x2*)(zrow + ZC_NQ + g * 256 + h * 64 + dq);
        float q0 = bf2f(qq.x & 0xffff), q1 = bf2f(qq.x >> 16), q2 = bf2f(qq.y & 0xffff), q3 = bf2f(qq.y >> 16);
        float ss = q0 * q0 + q1 * q1 + q2 * q2 + q3 * q3;
        ss += __shfl_xor(ss, 1); ss += __shfl_xor(ss, 2); ss += __shfl_xor(ss, 4); ss += __shfl_xor(ss, 8);
        const float rs = rsqrtf(ss * (1.f / 64.f) + EPS) * (0.125f * LOG2E);
        const f32x4 gq = *(const f32x4*)(a.in[I_QN] + l * 64 + dq);
        LDS_FENCE();
        *(LAS f32x4*)(qs + h * 64 + dq) = (f32x4){q0 * rs * gq[0], q1 * rs * gq[1], q2 * rs * gq[2], q3 * rs * gq[3]};
        LDS_FENCE();
    }
    const int nvis = (t >= 31) ? (((t - 31) >> 4) + 1) : 0;
    const bf16_t* kc = (const bf16_t*)(a.ws + WS_KCMP) + (size_t)((b * 2 + g) * 128) * 64;
    const bf16_t* vc = (const bf16_t*)(a.ws + WS_VCMP) + (size_t)((b * 2 + g) * 128) * 64;
    f32x4 ocmp = (f32x4){0.f, 0.f, 0.f, 0.f};
    float imp = 0.f;
    {
        const bool v1 = lane < nvis, v2 = lane + 64 < nvis;
        const f32x4 s1 = dot4(kc + (size_t)lane * 64, qs), s2 = dot4(kc + (size_t)(lane + 64) * 64, qs);
        f32x4 p1, p2;
#pragma unroll
        for (int h = 0; h < 4; ++h) {
            const float m = wave_max(fmaxf(v1 ? s1[h] : -1e30f, v2 ? s2[h] : -1e30f));
            p1[h] = v1 ? exp2f(s1[h] - m) : 0.f; p2[h] = v2 ? exp2f(s2[h] - m) : 0.f;
            const float inv = 1.f / fmaxf(wave_sum(p1[h] + p2[h]), 1e-30f);
            p1[h] *= inv; p2[h] *= inv;
        }
        LDS_FENCE();
        pbuf[lane] = p1; pbuf[lane + 64] = p2;
        LDS_FENCE();
        {
            const int j = lane & 31;
            const f32x4 pa = pbuf[4 * j], pb = pbuf[4 * j + 1], pc = pbuf[4 * j + 2], pd = pbuf[4 * j + 3];
            f32x4 pe = (f32x4){0.f, 0.f, 0.f, 0.f}; if (j > 0) pe = pbuf[4 * j - 1];
#pragma unroll
            for (int h = 0; h < 4; ++h) imp += pa[h] + pb[h] + pc[h] + 0.5f * pd[h] + 0.5f * pe[h];
        }
        for (int n = 0; n < nvis; ++n) {
            const f32x4 pp = pbuf[n];
            const float v = bf2f(vc[(size_t)n * 64 + lane]);
            ocmp[0] += pp[0] * v; ocmp[1] += pp[1] * v; ocmp[2] += pp[2] * v; ocmp[3] += pp[3] * v;
        }
        LDS_FENCE();
    }
    const int tb = t >> 6;
    unsigned mask;
    {
        const int j = lane & 31;
        const bool elig = j <= tb, forced = (j == 0) || (j == tb) || (j == tb - 1);
        const float sc = elig ? (imp + (forced ? 1e4f : 0.f)) : -1.0f;
        int rank = 0;
#pragma unroll
        for (int jj = 0; jj < 32; ++jj) { const float o = __uint_as_float(__builtin_amdgcn_readlane(__float_as_uint(sc), jj)); rank += (o > sc || (o == sc && jj < j)) ? 1 : 0; }
        mask = (unsigned)(__ballot(rank < 8 && lane < 32) & 0xffffffffull);
    }
    f32x4 ms = (f32x4){-1e30f, -1e30f, -1e30f, -1e30f}, lsl = (f32x4){0.f, 0.f, 0.f, 0.f}, os = (f32x4){0.f, 0.f, 0.f, 0.f};
    const bf16_t* ksn = (const bf16_t*)(a.ws + WS_KSN) + (size_t)b * SEQ * 128 + g * 64;
    for (int j = 0; j <= tb; ++j) {
        if (!((mask >> j) & 1u)) continue;
        const int key = 64 * j + lane; const bool valid = key <= t;
        const f32x4 s = dot4(ksn + (size_t)key * 128, qs);
        const int nk = min(64, t - 64 * j + 1);
        blk_step(s, valid, Z + ((size_t)b * SEQ + 64 * j) * ZW + ZC_VS + g * 64, ZW, nk, pbuf, lane, ms, lsl, os);
    }
    f32x4 mw = (f32x4){-1e30f, -1e30f, -1e30f, -1e30f}, lw = (f32x4){0.f, 0.f, 0.f, 0.f}, ow = (f32x4){0.f, 0.f, 0.f, 0.f};
    const bf16_t* kwn = (const bf16_t*)(a.ws + WS_KWN) + (size_t)b * SEQ * 128 + g * 64;
    for (int j = max(0, tb - 4); j <= tb; ++j) {
        const int key = 64 * j + lane; const bool valid = (key <= t) && (key > t - 256);
        const f32x4 s = dot4(kwn + (size_t)key * 128, qs);
        const int nk = min(64, t - 64 * j + 1);
        blk_step(s, valid, Z + ((size_t)b * SEQ + 64 * j) * ZW + ZC_VW + g * 64, ZW, nk, pbuf, lane, mw, lw, ow);
    }
    bf16_t* MIX = (bf16_t*)(a.ws + WS_MIX);
#pragma unroll
    for (int h = 0; h < 4; ++h) {
        const float l1 = wave_sum(lsl[h]), l2 = wave_sum(lw[h]);
        const bf16_t* gp = zrow + ZC_NG + (g * 4 + h) * 3;
        const float g0 = 1.f / (1.f + __expf(-bf2f(gp[0]))), g1 = 1.f / (1.f + __expf(-bf2f(gp[1]))), g2 = 1.f / (1.f + __expf(-bf2f(gp[2])));
        const float o = g0 * ocmp[h] + g1 * os[h] / fmaxf(l1, 1e-30f) + g2 * ow[h] / fmaxf(l2, 1e-30f);
        MIX[row * DM + 512 + (g * 4 + h) * 64 + lane] = (bf16_t)f2bf(o);
    }
}

__device__ __forceinline__ void phase_nsa(const KArgs& a, int l, LAS unsigned char* lds, int wave, int lane) {
    LAS float* qs = (LAS float*)(lds + wave * 4096);
    LAS f32x4* pbuf = (LAS f32x4*)(lds + wave * 4096 + 1024);
    const int gw = blockIdx.x * NWAVES + wave, NGW = gridDim.x * NWAVES;
    for (int task = gw; task < NB * 2 * SEQ; task += NGW) {
        const int bg = task >> 11, t = task & (SEQ - 1);
        nsa_task(a, l, bg >> 1, bg & 1, t, qs, pbuf, lane);
    }
}

typedef float f32x16 __attribute__((ext_vector_type(16)));
typedef short s16x4 __attribute__((ext_vector_type(4)));
constexpr int KST = 144, VST = 192;
constexpr int L_KC = 0, L_VC = 18432, L_KT = 43008, L_VT = 61440, L_IMP = 86016, L_SEL = 102400, L_UNI = 102656;
__device__ __forceinline__ int crow(int r, int hi) { return (r & 3) + 8 * (r >> 2) + 4 * hi; }
__device__ __forceinline__ s16x4 tr_read(const LAS unsigned char* p) { return __builtin_bit_cast(s16x4, __builtin_amdgcn_ds_read_tr16_b64_v4i16((LAS s16x4*)p)); }
__device__ __forceinline__ bf16x8 pack8(const f32x16& P, int base) {
    u32x4 w; w.x = pg8::cvt_pk_bf16(P[base + 0], P[base + 1]); w.y = pg8::cvt_pk_bf16(P[base + 2], P[base + 3]); w.z = pg8::cvt_pk_bf16(P[base + 4], P[base + 5]); w.w = pg8::cvt_pk_bf16(P[base + 6], P[base + 7]);
    return __builtin_bit_cast(bf16x8, w);
}
__device__ __forceinline__ void pv_step(f32x16 (&o)[2], const LAS unsigned char* vt, int s, bf16x8 bfrag, int lane) {
    const int i = lane & 15, hi = lane >> 5, dh = (lane >> 4) & 1;
    const LAS unsigned char* p = vt + (16 * s + 4 * hi + (i >> 2)) * VST + (16 * dh + 4 * (i & 3)) * 2;
#pragma unroll
    for (int dt = 0; dt < 2; ++dt) {
        const s16x4 lo = tr_read(p + dt * 64), hh = tr_read(p + dt * 64 + 8 * VST);
        const bf16x8 af = (bf16x8){lo[0], lo[1], lo[2], lo[3], hh[0], hh[1], hh[2], hh[3]};
        o[dt] = __builtin_amdgcn_mfma_f32_32x32x16_bf16(af, bfrag, o[dt], 0, 0, 0);
    }
}
__device__ __forceinline__ void nsa_mfma_item(const KArgs& a, int l, int b, int g, int tq, LAS unsigned char* lds, int wave, int lane_in, float shiftc) {
    int lane = lane_in; asm volatile("" : "+v"(lane));
    const int tid = wave * 64 + lane;
    const bf16_t* Z = (const bf16_t*)(a.ws + WS_Z);
    const int t0 = tq * 64, tb = tq; const size_t rowbase = (size_t)b * SEQ;
    const int c = lane & 31, hi = lane >> 5, tl = c >> 2, h = c & 3;
    const int tok = 8 * wave + tl, t = t0 + tok;
    __syncthreads();
    {
        const bf16_t* kc = (const bf16_t*)(a.ws + WS_KCMP) + (size_t)((b * 2 + g) * 128) * 64;
        const bf16_t* vc = (const bf16_t*)(a.ws + WS_VCMP) + (size_t)((b * 2 + g) * 128) * 64;
#pragma unroll
        for (int r = 0; r < 2; ++r) { const int e = tid + r * NTHREADS, key = e >> 3, ch = e & 7;
            const u32x4 kk = *(const u32x4*)(kc + key * 64 + ch * 8), vv = *(const u32x4*)(vc + key * 64 + ch * 8);
            *(LAS u32x4*)(lds + L_KC + key * KST + ch * 16) = kk; *(LAS u32x4*)(lds + L_VC + key * VST + ch * 16) = vv; }
    }
    const int skey = tid >> 3, sch = tid & 7;
    u32x4 kregA, vregA, kregB = (u32x4){0u, 0u, 0u, 0u}, vregB = (u32x4){0u, 0u, 0u, 0u};
    const bf16_t* ksn = (const bf16_t*)(a.ws + WS_KSN); const bf16_t* kwn = (const bf16_t*)(a.ws + WS_KWN);
#define NSA_LOAD_TILE(idx, KR, VR) do { const int ty_ = (idx) >> 5, j_ = (idx) & 31; const size_t row_ = rowbase + 64 * j_ + skey; \
        KR = *(const u32x4*)((ty_ ? kwn : ksn) + row_ * 128 + g * 64 + sch * 8); \
        VR = *(const u32x4*)(Z + row_ * ZW + (ty_ ? ZC_VW : ZC_VS) + g * 64 + sch * 8); } while (0)
    NSA_LOAD_TILE(0, kregA, vregA);
    const bf16_t* zrow = Z + (rowbase + t) * ZW;
    bf16x8 qf[4];
    {
        u32x4 raw[4]; float ss = 0.f;
#pragma unroll
        for (int ks = 0; ks < 4; ++ks) { raw[ks] = *(const u32x4*)(zrow + ZC_NQ + g * 256 + h * 64 + 16 * ks + 8 * hi);
#pragma unroll
            for (int i = 0; i < 4; ++i) { const float x0 = bf2f(raw[ks][i] & 0xffff), x1 = bf2f(raw[ks][i] >> 16); ss += x0 * x0 + x1 * x1; } }
        ss += __shfl_xor(ss, 32);
        const float rs = rsqrtf(ss * (1.f / 64.f) + EPS) * (0.125f * LOG2E);
#pragma unroll
        for (int ks = 0; ks < 4; ++ks) { const float* gp = a.in[I_QN] + l * 64 + 16 * ks + 8 * hi; const f32x4 ga = *(const f32x4*)gp, gb = *(const f32x4*)(gp + 4);
            u32x4 w;
            w.x = pg8::cvt_pk_bf16(bf2f(raw[ks][0] & 0xffff) * rs * ga[0], bf2f(raw[ks][0] >> 16) * rs * ga[1]);
            w.y = pg8::cvt_pk_bf16(bf2f(raw[ks][1] & 0xffff) * rs * ga[2], bf2f(raw[ks][1] >> 16) * rs * ga[3]);
            w.z = pg8::cvt_pk_bf16(bf2f(raw[ks][2] & 0xffff) * rs * gb[0], bf2f(raw[ks][2] >> 16) * rs * gb[1]);
            w.w = pg8::cvt_pk_bf16(bf2f(raw[ks][3] & 0xffff) * rs * gb[2], bf2f(raw[ks][3] >> 16) * rs * gb[3]);
            qf[ks] = __builtin_bit_cast(bf16x8, w); }
    }
    float g0, g1, g2;
    { const bf16_t* gp = zrow + ZC_NG + (g * 4 + h) * 3; g0 = 1.f / (1.f + __expf(-bf2f(gp[0]))); g1 = 1.f / (1.f + __expf(-bf2f(gp[1]))); g2 = 1.f / (1.f + __expf(-bf2f(gp[2]))); }
    __syncthreads();
    f32x16 otot[2];
    unsigned mymask;
    {
        f32x16 pc[4];
#pragma unroll
        for (int kt = 0; kt < 4; ++kt) { pc[kt] = (f32x16){};
#pragma unroll
            for (int ks = 0; ks < 4; ++ks) { const bf16x8 kf = *(const LAS bf16x8*)(lds + L_KC + (32 * kt + c) * KST + (16 * ks + 8 * hi) * 2);
                pc[kt] = __builtin_amdgcn_mfma_f32_32x32x16_bf16(kf, qf[ks], pc[kt], 0, 0, 0); } }
        const int nvis = (t >= 31) ? (((t - 31) >> 4) + 1) : 0;
        float mx = -1e30f;
#pragma unroll
        for (int kt = 0; kt < 4; ++kt)
#pragma unroll
            for (int r = 0; r < 16; ++r) { const int n = 32 * kt + crow(r, hi); const float sv = (n < nvis) ? pc[kt][r] : -INFINITY; pc[kt][r] = sv; mx = fmaxf(mx, sv); }
        mx = fmaxf(mx, __shfl_xor(mx, 32));
        float sum = 0.f;
#pragma unroll
        for (int kt = 0; kt < 4; ++kt)
#pragma unroll
            for (int r = 0; r < 16; ++r) { const float p = __builtin_amdgcn_exp2f(pc[kt][r] - mx); pc[kt][r] = p; sum += p; }
        sum += __shfl_xor(sum, 32);
        const float inv = 1.f / fmaxf(sum, 1e-30f);
#pragma unroll
        for (int kt = 0; kt < 4; ++kt)
#pragma unroll
            for (int r = 0; r < 16; ++r) pc[kt][r] *= inv;
        LAS float* impA = (LAS float*)(lds + L_IMP + wave * 2048); LAS float* impC = impA + 256;
#pragma unroll
        for (int kt = 0; kt < 4; ++kt)
#pragma unroll
            for (int gq = 0; gq < 4; ++gq) {
                float A = pc[kt][4 * gq] + pc[kt][4 * gq + 1] + pc[kt][4 * gq + 2] + 0.5f * pc[kt][4 * gq + 3], C = 0.5f * pc[kt][4 * gq + 3];
                A += __shfl_xor(A, 1); A += __shfl_xor(A, 2); C += __shfl_xor(C, 1); C += __shfl_xor(C, 2);
                const int j = 8 * kt + 2 * gq + hi;
                if (h == 0) { impA[tl * 32 + j] = A; if (j < 31) impC[tl * 32 + j + 1] = C; }
            }
        if (h == 0 && hi == 0) impC[tl * 32] = 0.f;
        f32x16 oc[2]; oc[0] = (f32x16){}; oc[1] = (f32x16){};
#pragma unroll
        for (int s8 = 0; s8 < 8; ++s8) pv_step(oc, lds + L_VC, s8, pack8(pc[s8 >> 1], 8 * (s8 & 1)), lane);
#pragma unroll
        for (int dt = 0; dt < 2; ++dt)
#pragma unroll
            for (int r = 0; r < 16; ++r) otot[dt][r] = g0 * oc[dt][r];
        LDS_FENCE();
        const int tk = lane >> 3, jg = lane & 7;
        const LAS float* ia = impA + tk * 32; const LAS float* ic = impC + tk * 32;
        float sc[32];
#pragma unroll
        for (int q4 = 0; q4 < 8; ++q4) { const f32x4 x = *(const LAS f32x4*)(ia + 4 * q4) + *(const LAS f32x4*)(ic + 4 * q4);
#pragma unroll
            for (int u = 0; u < 4; ++u) { const int j = 4 * q4 + u; const bool forced = (j == 0) || (j == tb) || (j == tb - 1); sc[j] = (j <= tb) ? (x[u] + (forced ? 1e4f : 0.f)) : -1.0f; } }
        float so[4];
        { const f32x4 x = *(const LAS f32x4*)(ia + 4 * jg) + *(const LAS f32x4*)(ic + 4 * jg);
#pragma unroll
            for (int u = 0; u < 4; ++u) { const int j = 4 * jg + u; const bool forced = (j == 0) || (j == tb) || (j == tb - 1); so[u] = (j <= tb) ? (x[u] + (forced ? 1e4f : 0.f)) : -1.0f; } }
        unsigned part = 0u;
#pragma unroll
        for (int u = 0; u < 4; ++u) { const int j = 4 * jg + u; int rank = 0;
#pragma unroll
            for (int jj = 0; jj < 32; ++jj) rank += (sc[jj] > so[u] || (sc[jj] == so[u] && jj < j)) ? 1 : 0;
            part |= (rank < 8 ? 1u : 0u) << j; }
        part |= __shfl_xor(part, 1); part |= __shfl_xor(part, 2); part |= __shfl_xor(part, 4);
        LAS unsigned* selm = (LAS unsigned*)(lds + L_SEL);
        if (jg == 0) selm[wave * 8 + tk] = part;
        unsigned uni = part; uni |= __shfl_xor(uni, 8); uni |= __shfl_xor(uni, 16); uni |= __shfl_xor(uni, 32);
        if (lane == 0) ((LAS unsigned*)(lds + L_UNI))[wave] = uni;
        LDS_FENCE();
        mymask = selm[wave * 8 + tl];
    }
    __syncthreads();
    unsigned uniall = 0u;
    { const LAS unsigned* up = (const LAS unsigned*)(lds + L_UNI);
#pragma unroll
        for (int w = 0; w < 8; ++w) uniall |= up[w]; }
    uniall = __builtin_amdgcn_readfirstlane(uniall);
    const unsigned upto = (2u << tb) - 1u;
    const int wlo = tb - 4 > 0 ? tb - 4 : 0;
    unsigned long long list = (unsigned long long)(uniall & upto) | ((unsigned long long)(upto & ~((1u << wlo) - 1u)) << 32);
    float lsum = 0.f; f32x16 o[2]; o[0] = (f32x16){}; o[1] = (f32x16){};
    int curA = 0, curB = -1; list &= list - 1ull;
    int buf = 0, prevtype = 0;
    while (curA >= 0) {
        LAS unsigned char* sb = lds + buf * 43008;
        *(LAS u32x4*)(sb + skey * KST + sch * 16) = kregA; *(LAS u32x4*)(sb + 18432 + skey * VST + sch * 16) = vregA;
        if (curB >= 0) { *(LAS u32x4*)(sb + (64 + skey) * KST + sch * 16) = kregB; *(LAS u32x4*)(sb + 18432 + (64 + skey) * VST + sch * 16) = vregB; }
        __syncthreads();
        int nxtA = -1, nxtB = -1;
        if (list) { nxtA = __builtin_ctzll(list); list &= list - 1ull; NSA_LOAD_TILE(nxtA, kregA, vregA);
            if (list) { const int nb_ = __builtin_ctzll(list); if ((nb_ >> 5) == (nxtA >> 5)) { nxtB = nb_; list &= list - 1ull; NSA_LOAD_TILE(nxtB, kregB, vregB); } } }
        const int type = curA >> 5, jA = curA & 31, jB = curB & 31; const bool hasB = curB >= 0;
        if (type != prevtype) {
            const float lt = lsum + __shfl_xor(lsum, 32); const float f = g1 / fmaxf(lt, 1e-30f);
#pragma unroll
            for (int dt = 0; dt < 2; ++dt)
#pragma unroll
                for (int r = 0; r < 16; ++r) { otot[dt][r] += f * o[dt][r]; o[dt][r] = 0.f; }
            lsum = 0.f; prevtype = type;
        }
        int kloA, khiA, kloB = 0, khiB = -1;
        if (type == 0) { kloA = 0; khiA = ((mymask >> jA) & 1u) ? (jA == tb ? tok : 63) : -1; if (hasB) khiB = ((mymask >> jB) & 1u) ? (jB == tb ? tok : 63) : -1; }
        else { kloA = (jA == tb - 4) ? tok + 1 : 0; khiA = (jA == tb) ? tok : 63; if (hasB) { kloB = (jB == tb - 4) ? tok + 1 : 0; khiB = (jB == tb) ? tok : 63; } }
        const bool colA = khiA >= kloA, colB = khiB >= kloB;
        if (__any(colA || colB)) {
            const LAS unsigned char* kt_ = sb; const LAS unsigned char* vt_ = sb + 18432;
            f32x16 p0 = (f32x16){}, p1 = (f32x16){}, p2 = (f32x16){}, p3 = (f32x16){};
            __builtin_amdgcn_s_setprio(1);
#pragma unroll
            for (int ks = 0; ks < 4; ++ks) {
                const bf16x8 k0 = *(const LAS bf16x8*)(kt_ + c * KST + (16 * ks + 8 * hi) * 2), k1 = *(const LAS bf16x8*)(kt_ + (c + 32) * KST + (16 * ks + 8 * hi) * 2);
                p0 = __builtin_amdgcn_mfma_f32_32x32x16_bf16(k0, qf[ks], p0, 0, 0, 0); p1 = __builtin_amdgcn_mfma_f32_32x32x16_bf16(k1, qf[ks], p1, 0, 0, 0);
            }
            if (hasB) {
#pragma unroll
                for (int ks = 0; ks < 4; ++ks) {
                    const bf16x8 k2 = *(const LAS bf16x8*)(kt_ + (c + 64) * KST + (16 * ks + 8 * hi) * 2), k3 = *(const LAS bf16x8*)(kt_ + (c + 96) * KST + (16 * ks + 8 * hi) * 2);
                    p2 = __builtin_amdgcn_mfma_f32_32x32x16_bf16(k2, qf[ks], p2, 0, 0, 0); p3 = __builtin_amdgcn_mfma_f32_32x32x16_bf16(k3, qf[ks], p3, 0, 0, 0);
                }
            }
            __builtin_amdgcn_s_setprio(0);
            if ((jA == tb) || (type == 1 && jA == tb - 4)) {
#pragma unroll
                for (int r = 0; r < 16; ++r) { const int k0 = crow(r, hi), k1 = k0 + 32;
                    p0[r] = (k0 >= kloA && k0 <= khiA) ? p0[r] : -INFINITY; p1[r] = (k1 >= kloA && k1 <= khiA) ? p1[r] : -INFINITY; }
            }
            if (hasB && ((jB == tb) || (type == 1 && jB == tb - 4))) {
#pragma unroll
                for (int r = 0; r < 16; ++r) { const int k0 = crow(r, hi), k1 = k0 + 32;
                    p2[r] = (k0 >= kloB && k0 <= khiB) ? p2[r] : -INFINITY; p3[r] = (k1 >= kloB && k1 <= khiB) ? p3[r] : -INFINITY; }
            }
            const float mrefA = colA ? shiftc : INFINITY;
            const pg8::f32x2_t mrA = {mrefA, mrefA}; pg8::f32x2_t ps0 = {0.f, 0.f}, ps1 = {0.f, 0.f};
#pragma unroll
            for (int r = 0; r < 16; r += 2) { pg8::f32x2_t v0 = {p0[r], p0[r + 1]}, v1 = {p1[r], p1[r + 1]}; v0 -= mrA; v1 -= mrA;
                v0.x = __builtin_amdgcn_exp2f(v0.x); v0.y = __builtin_amdgcn_exp2f(v0.y); v1.x = __builtin_amdgcn_exp2f(v1.x); v1.y = __builtin_amdgcn_exp2f(v1.y);
                ps0 += v0; ps1 += v1; p0[r] = v0.x; p0[r + 1] = v0.y; p1[r] = v1.x; p1[r + 1] = v1.y; }
            { const pg8::f32x2_t pt = ps0 + ps1; lsum += pt.x + pt.y; }
#pragma unroll
            for (int s = 0; s < 4; ++s) pv_step(o, vt_, s, (s < 2) ? pack8(p0, 8 * (s & 1)) : pack8(p1, 8 * (s & 1)), lane);
            if (hasB) {
                const float mrefB = colB ? shiftc : INFINITY;
                const pg8::f32x2_t mrB = {mrefB, mrefB}; pg8::f32x2_t ps2 = {0.f, 0.f}, ps3 = {0.f, 0.f};
#pragma unroll
                for (int r = 0; r < 16; r += 2) { pg8::f32x2_t v0 = {p2[r], p2[r + 1]}, v1 = {p3[r], p3[r + 1]}; v0 -= mrB; v1 -= mrB;
                    v0.x = __builtin_amdgcn_exp2f(v0.x); v0.y = __builtin_amdgcn_exp2f(v0.y); v1.x = __builtin_amdgcn_exp2f(v1.x); v1.y = __builtin_amdgcn_exp2f(v1.y);
                    ps2 += v0; ps3 += v1; p2[r] = v0.x; p2[r + 1] = v0.y; p3[r] = v1.x; p3[r + 1] = v1.y; }
                { const pg8::f32x2_t pt = ps2 + ps3; lsum += pt.x + pt.y; }
#pragma unroll
                for (int s = 0; s < 4; ++s) pv_step(o, vt_, 4 + s, (s < 2) ? pack8(p2, 8 * (s & 1)) : pack8(p3, 8 * (s & 1)), lane);
            }
        }
        buf ^= 1; curA = nxtA; curB = nxtB;
    }
    {
        const float lt = lsum + __shfl_xor(lsum, 32); const float f = g2 / fmaxf(lt, 1e-30f);
#pragma unroll
        for (int dt = 0; dt < 2; ++dt)
#pragma unroll
            for (int r = 0; r < 16; ++r) otot[dt][r] += f * o[dt][r];
    }
    bf16_t* orow = (bf16_t*)(a.ws + WS_MIX) + (rowbase + t) * DM + 512 + (g * 4 + h) * 64 + 4 * hi;
#pragma unroll
    for (int dt = 0; dt < 2; ++dt)
#pragma unroll
        for (int gq = 0; gq < 4; ++gq) { u32x2 w; w.x = pg8::cvt_pk_bf16(otot[dt][4 * gq], otot[dt][4 * gq + 1]); w.y = pg8::cvt_pk_bf16(otot[dt][4 * gq + 2], otot[dt][4 * gq + 3]);
            *(u32x2*)(orow + 32 * dt + 8 * gq) = w; }
#undef NSA_LOAD_TILE
}
__device__ __forceinline__ void phase_nsa_mfma(const KArgs& a, int l, LAS unsigned char* lds, int wave, int lane) {
    const float gq = wave_max(fabsf(a.in[I_QN][l * 64 + lane])), gk = wave_max(fabsf(a.in[I_KN][l * 64 + lane]));
    const float shiftc = __uint_as_float(__builtin_amdgcn_readfirstlane(__float_as_uint(fmaxf(0.f, 64.f * 0.125f * LOG2E * gq * gk - 60.f))));
    for (int it = blockIdx.x; it < NB * 2 * 32; it += gridDim.x) {
        const int k = it >> 8, pos = it & 255, grp = pos >> 6, bg = pos & 63;
        const int tq = 31 - (4 * k + ((k & 1) ? 3 - grp : grp));
        nsa_mfma_item(a, l, bg >> 1, bg & 1, tq, lds, wave, lane, shiftc);
    }
}

constexpr int N2_IMP = 43008, N2_SEL = 59392, N2_UNI = 59904, N2_OTP = 60416;
__device__ __forceinline__ void nsa2_softmax(f32x16& P, int kbase, bool col, bool bnd, int klo, int khi, int hi, float shiftc, float& lsum) {
    if (bnd) {
#pragma unroll
        for (int r = 0; r < 16; ++r) { const int k0 = kbase + crow(r, hi); P[r] = (k0 >= klo && k0 <= khi) ? P[r] : -INFINITY; }
    }
    const float mref = col ? shiftc : INFINITY; const pg8::f32x2_t mr = {mref, mref}; pg8::f32x2_t ps = {0.f, 0.f};
#pragma unroll
    for (int r = 0; r < 16; r += 2) { pg8::f32x2_t v = {P[r], P[r + 1]}; v -= mr; v.x = __builtin_amdgcn_exp2f(v.x); v.y = __builtin_amdgcn_exp2f(v.y); ps += v; P[r] = v.x; P[r + 1] = v.y; }
    lsum += ps.x + ps.y;
}
__device__ __forceinline__ void nsa2_item(const KArgs& a, int l, int b, int g, int T, LAS unsigned char* lds, int wave, int lane_in, float shiftc) {
    (void)lane_in; int lane = (int)__builtin_amdgcn_mbcnt_hi(~0u, __builtin_amdgcn_mbcnt_lo(~0u, 0u)); asm volatile("" : "+v"(lane));
    const int tid = wave * 64 + lane;
    const bf16_t* Z = (const bf16_t*)(a.ws + WS_Z);
    const int t0 = T * 128; const size_t rowbase = (size_t)b * SEQ;
    const int c = lane & 31, hi = lane >> 5, tl = c >> 2, h = c & 3;
    const int tok = 8 * wave + tl;
    __syncthreads();
    {
        const bf16_t* kc = (const bf16_t*)(a.ws + WS_KCMP) + (size_t)((b * 2 + g) * 128) * 64;
        const bf16_t* vc = (const bf16_t*)(a.ws + WS_VCMP) + (size_t)((b * 2 + g) * 128) * 64;
#pragma unroll
        for (int r = 0; r < 2; ++r) { const int e = tid + r * NTHREADS, key = e >> 3, ch = e & 7;
            const u32x4 kk = *(const u32x4*)(kc + key * 64 + ch * 8), vv = *(const u32x4*)(vc + key * 64 + ch * 8);
            *(LAS u32x4*)(lds + L_KC + key * KST + ch * 16) = kk; *(LAS u32x4*)(lds + L_VC + key * VST + ch * 16) = vv; }
    }
    const int skey = tid >> 3, sch = tid & 7;
    u32x4 kreg, vreg;
    const bf16_t* ksn = (const bf16_t*)(a.ws + WS_KSN); const bf16_t* kwn = (const bf16_t*)(a.ws + WS_KWN);
#define N2_LOAD_TILE(idx) do { const int ty_ = (idx) >> 5, j_ = (idx) & 31; const size_t row_ = rowbase + 64 * j_ + skey; \
        kreg = *(const u32x4*)((ty_ ? kwn : ksn) + row_ * 128 + g * 64 + sch * 8); \
        vreg = *(const u32x4*)(Z + row_ * ZW + (ty_ ? ZC_VW : ZC_VS) + g * 64 + sch * 8); } while (0)
    N2_LOAD_TILE(0);
    bf16x8 qf[2][4]; float g0[2]; unsigned g12[2];
    __syncthreads();
    LAS unsigned* otp = (LAS unsigned*)(lds + N2_OTP) + tid;
    unsigned uniw = 0u;
#pragma unroll
    for (int s = 0; s < 2; ++s) {
        {
        const bf16_t* zrow = Z + (rowbase + t0 + 64 * s + tok) * ZW;
        u32x4 raw[4]; float ss = 0.f;
#pragma unroll
        for (int ks = 0; ks < 4; ++ks) { raw[ks] = *(const u32x4*)(zrow + ZC_NQ + g * 256 + h * 64 + 16 * ks + 8 * hi);
#pragma unroll
            for (int i = 0; i < 4; ++i) { const float x0 = bf2f(raw[ks][i] & 0xffff), x1 = bf2f(raw[ks][i] >> 16); ss += x0 * x0 + x1 * x1; } }
        ss = x32_sum(ss);
        const float rs = rsqrtf(ss * (1.f / 64.f) + EPS) * (0.125f * LOG2E);
#pragma unroll
        for (int ks = 0; ks < 4; ++ks) { const float* gp = a.in[I_QN] + l * 64 + 16 * ks + 8 * hi; const f32x4 ga = *(const f32x4*)gp, gb = *(const f32x4*)(gp + 4);
            u32x4 w;
            w.x = pg8::cvt_pk_bf16(bf2f(raw[ks][0] & 0xffff) * rs * ga[0], bf2f(raw[ks][0] >> 16) * rs * ga[1]);
            w.y = pg8::cvt_pk_bf16(bf2f(raw[ks][1] & 0xffff) * rs * ga[2], bf2f(raw[ks][1] >> 16) * rs * ga[3]);
            w.z = pg8::cvt_pk_bf16(bf2f(raw[ks][2] & 0xffff) * rs * gb[0], bf2f(raw[ks][2] >> 16) * rs * gb[1]);
            w.w = pg8::cvt_pk_bf16(bf2f(raw[ks][3] & 0xffff) * rs * gb[2], bf2f(raw[ks][3] >> 16) * rs * gb[3]);
            if (s == 1 && ks == 3) *(LAS u32x4*)(lds + 125952 + tid * 16) = w; else qf[s][ks] = __builtin_bit_cast(bf16x8, w); }
        const bf16_t* gp = zrow + ZC_NG + (g * 4 + h) * 3;
        g0[s] = 1.f / (1.f + __expf(-bf2f(gp[0])));
        g12[s] = pg8::cvt_pk_bf16(1.f / (1.f + __expf(-bf2f(gp[1]))), 1.f / (1.f + __expf(-bf2f(gp[2]))));
        }
        const int t = t0 + 64 * s + tok, tb = 2 * T + s;
        f32x16 pc[4];
#pragma unroll
        for (int kt = 0; kt < 4; ++kt) { pc[kt] = (f32x16){};
#pragma unroll
            for (int ks = 0; ks < 4; ++ks) { const bf16x8 kf = *(const LAS bf16x8*)(lds + L_KC + (32 * kt + c) * KST + (16 * ks + 8 * hi) * 2);
                pc[kt] = __builtin_amdgcn_mfma_f32_32x32x16_bf16(kf, (s == 1 && ks == 3) ? *(const LAS bf16x8*)(lds + 125952 + tid * 16) : qf[s][ks], pc[kt], 0, 0, 0); } }
        const int nvis = (t >= 31) ? (((t - 31) >> 4) + 1) : 0;
        float mx = -1e30f;
#pragma unroll
        for (int kt = 0; kt < 4; ++kt)
#pragma unroll
            for (int r = 0; r < 16; ++r) { const int n = 32 * kt + crow(r, hi); const float sv = (n < nvis) ? pc[kt][r] : -INFINITY; pc[kt][r] = sv; mx = fmaxf(mx, sv); }
        mx = x32_max(mx);
        float sum = 0.f;
#pragma unroll
        for (int kt = 0; kt < 4; ++kt)
#pragma unroll
            for (int r = 0; r < 16; ++r) { const float p = __builtin_amdgcn_exp2f(pc[kt][r] - mx); pc[kt][r] = p; sum += p; }
        sum = x32_sum(sum);
        const float inv = 1.f / fmaxf(sum, 1e-30f);
#pragma unroll
        for (int kt = 0; kt < 4; ++kt)
#pragma unroll
            for (int r = 0; r < 16; ++r) pc[kt][r] *= inv;
        LAS float* impA = (LAS float*)(lds + N2_IMP + wave * 2048); LAS float* impC = impA + 256;
        LDS_FENCE();
#pragma unroll
        for (int kt = 0; kt < 4; ++kt)
#pragma unroll
            for (int gq = 0; gq < 4; ++gq) {
                float A = pc[kt][4 * gq] + pc[kt][4 * gq + 1] + pc[kt][4 * gq + 2] + 0.5f * pc[kt][4 * gq + 3], C = 0.5f * pc[kt][4 * gq + 3];
                A += swz_f<1>(A); A += swz_f<2>(A); C += swz_f<1>(C); C += swz_f<2>(C);
                const int j = 8 * kt + 2 * gq + hi;
                if (h == 0) { impA[tl * 32 + j] = A; if (j < 31) impC[tl * 32 + j + 1] = C; }
            }
        if (h == 0 && hi == 0) impC[tl * 32] = 0.f;
        f32x16 oc[2]; oc[0] = (f32x16){}; oc[1] = (f32x16){};
#pragma unroll
        for (int s8 = 0; s8 < 8; ++s8) pv_step(oc, lds + L_VC, s8, pack8(pc[s8 >> 1], 8 * (s8 & 1)), lane);
#pragma unroll
        for (int dt = 0; dt < 2; ++dt)
#pragma unroll
            for (int r = 0; r < 16; r += 2) otp[(16 * s + 8 * dt + (r >> 1)) * 512] = pg8::cvt_pk_bf16(g0[s] * oc[dt][r], g0[s] * oc[dt][r + 1]);
        LDS_FENCE();
        const int tk = lane >> 3, jg = lane & 7;
        const LAS float* ia = impA + tk * 32; const LAS float* ic = impC + tk * 32;
        float sc[32];
#pragma unroll
        for (int q4 = 0; q4 < 8; ++q4) { const f32x4 x = *(const LAS f32x4*)(ia + 4 * q4) + *(const LAS f32x4*)(ic + 4 * q4);
#pragma unroll
            for (int u = 0; u < 4; ++u) { const int j = 4 * q4 + u; const bool forced = (j == 0) || (j == tb) || (j == tb - 1); sc[j] = (j <= tb) ? (x[u] + (forced ? 1e4f : 0.f)) : -1.0f; } }
        float so[4];
        { const f32x4 x = *(const LAS f32x4*)(ia + 4 * jg) + *(const LAS f32x4*)(ic + 4 * jg);
#pragma unroll
            for (int u = 0; u < 4; ++u) { const int j = 4 * jg + u; const bool forced = (j == 0) || (j == tb) || (j == tb - 1); so[u] = (j <= tb) ? (x[u] + (forced ? 1e4f : 0.f)) : -1.0f; } }
        unsigned part = 0u;
#pragma unroll
        for (int u = 0; u < 4; ++u) { const int j = 4 * jg + u; int rank = 0;
#pragma unroll
            for (int jj = 0; jj < 32; ++jj) rank += (sc[jj] > so[u] || (sc[jj] == so[u] && jj < j)) ? 1 : 0;
            part |= (rank < 8 ? 1u : 0u) << j; }
        part |= swz_u<1>(part); part |= swz_u<2>(part); part |= swz_u<4>(part);
        LAS unsigned* selm = (LAS unsigned*)(lds + N2_SEL) + s * 64;
        if (jg == 0) selm[wave * 8 + tk] = part;
        unsigned uni = part; uni |= swz_u<8>(uni); uni |= swz_u<16>(uni); uni = x32_or(uni);
        uniw |= uni & ((2u << tb) - 1u);
        LDS_FENCE();
        __builtin_amdgcn_sched_barrier(0);
    }
    LDS_FENCE();
    *(LAS bf16x8*)(lds + N2_IMP + wave * 2048 + lane * 16) = qf[1][2];
    if (lane == 0) ((LAS unsigned*)(lds + N2_UNI))[wave] = uniw;
    __syncthreads();
    unsigned uniall = 0u;
    { const LAS unsigned* up = (const LAS unsigned*)(lds + N2_UNI);
#pragma unroll
        for (int w = 0; w < 8; ++w) uniall |= up[w]; }
    uniall = __builtin_amdgcn_readfirstlane(uniall);
    const int tb0 = 2 * T, tb1 = 2 * T + 1;
    const unsigned upto = (2u << tb1) - 1u;
    const int wlo = tb0 - 4 > 0 ? tb0 - 4 : 0;
    unsigned long long list = (unsigned long long)(uniall & upto) | ((unsigned long long)(upto & ~((1u << wlo) - 1u)) << 32);
    float lsum[2] = {0.f, 0.f}; f32x16 o[2][2];
#pragma unroll
    for (int s = 0; s < 2; ++s) { o[s][0] = (f32x16){}; o[s][1] = (f32x16){}; }
    int cur = 0; list &= list - 1ull;
    int buf = 0, prevtype = 0;
    while (cur >= 0) {
        LAS unsigned char* sb = lds + buf * 21504;
        *(LAS u32x4*)(sb + skey * KST + sch * 16) = kreg; *(LAS u32x4*)(sb + 9216 + skey * VST + sch * 16) = vreg;
        __syncthreads();
        int nxt = -1;
        if (list) { nxt = __builtin_ctzll(list); list &= list - 1ull; N2_LOAD_TILE(nxt); }
        const int type = cur >> 5, j = cur & 31;
        if (type != prevtype) {
#pragma unroll
            for (int s = 0; s < 2; ++s) {
                const float lt = x32_sum(lsum[s]); const float f = __uint_as_float(g12[s] << 16) / fmaxf(lt, 1e-30f);
#pragma unroll
                for (int dt = 0; dt < 2; ++dt)
#pragma unroll
                    for (int r = 0; r < 16; r += 2) { const unsigned w = otp[(16 * s + 8 * dt + (r >> 1)) * 512];
                        otp[(16 * s + 8 * dt + (r >> 1)) * 512] = pg8::cvt_pk_bf16(__uint_as_float(w << 16) + f * o[s][dt][r], __uint_as_float(w & 0xffff0000u) + f * o[s][dt][r + 1]); o[s][dt][r] = 0.f; o[s][dt][r + 1] = 0.f; }
                lsum[s] = 0.f; }
            prevtype = type;
        }
        int klo[2], khi[2]; bool col[2], bnd[2], act[2];
#pragma unroll
        for (int s = 0; s < 2; ++s) { const int tb = 2 * T + s;
            if (type == 0) { const unsigned mm_ = ((const LAS unsigned*)(lds + N2_SEL))[s * 64 + wave * 8 + tl]; klo[s] = 0; khi[s] = (j <= tb && ((mm_ >> j) & 1u)) ? (j == tb ? tok : 63) : -1; bnd[s] = (j == tb); }
            else { const bool in = (j <= tb) && (j >= tb - 4); klo[s] = (j == tb - 4) ? tok + 1 : 0; khi[s] = in ? ((j == tb) ? tok : 63) : -1; bnd[s] = (j == tb) || (j == tb - 4); }
            col[s] = khi[s] >= klo[s]; act[s] = __any(col[s]); }
        if (act[0] || act[1]) {
            const LAS unsigned char* kt_ = sb; const LAS unsigned char* vt_ = sb + 9216;
            const int i = lane & 15, dh = (lane >> 4) & 1;
#pragma unroll
            for (int sub = 0; sub < 2; ++sub) {
                f32x16 p[2]; p[0] = (f32x16){}; p[1] = (f32x16){};
#pragma unroll
                for (int ks = 0; ks < 4; ++ks) {
                    const bf16x8 kf = *(const LAS bf16x8*)(kt_ + (c + 32 * sub) * KST + (16 * ks + 8 * hi) * 2);
#pragma unroll
                    for (int s = 0; s < 2; ++s) if (act[s]) p[s] = __builtin_amdgcn_mfma_f32_32x32x16_bf16(kf, (s == 1 && ks == 3) ? *(const LAS bf16x8*)(lds + 125952 + tid * 16) : (s == 1 && ks == 2) ? *(const LAS bf16x8*)(lds + N2_IMP + wave * 2048 + lane * 16) : qf[s][ks], p[s], 0, 0, 0);
                }
#pragma unroll
                for (int s = 0; s < 2; ++s) if (act[s]) nsa2_softmax(p[s], 32 * sub, col[s], bnd[s], klo[s], khi[s], hi, shiftc, lsum[s]);
#pragma unroll
                for (int s4 = 2 * sub; s4 < 2 * sub + 2; ++s4) {
                    const LAS unsigned char* pvp = vt_ + (16 * s4 + 4 * hi + (i >> 2)) * VST + (16 * dh + 4 * (i & 3)) * 2;
                    bf16x8 bfr[2];
#pragma unroll
                    for (int s = 0; s < 2; ++s) bfr[s] = pack8(p[s], 8 * (s4 & 1));
#pragma unroll
                    for (int dt = 0; dt < 2; ++dt) {
                        const s16x4 lo = tr_read(pvp + dt * 64), hh = tr_read(pvp + dt * 64 + 8 * VST);
                        const bf16x8 af = (bf16x8){lo[0], lo[1], lo[2], lo[3], hh[0], hh[1], hh[2], hh[3]};
#pragma unroll
                        for (int s = 0; s < 2; ++s) if (act[s]) o[s][dt] = __builtin_amdgcn_mfma_f32_32x32x16_bf16(af, bfr[s], o[s][dt], 0, 0, 0);
                    }
                }
            }
        }
        buf ^= 1; cur = nxt;
    }
#pragma unroll
    for (int s = 0; s < 2; ++s) {
        const float lt = x32_sum(lsum[s]); const float f = __uint_as_float(g12[s] & 0xffff0000u) / fmaxf(lt, 1e-30f);
        bf16_t* orow = (bf16_t*)(a.ws + WS_MIX) + (rowbase + t0 + 64 * s + tok) * DM + 512 + (g * 4 + h) * 64 + 4 * hi;
#pragma unroll
        for (int dt = 0; dt < 2; ++dt)
#pragma unroll
            for (int gq = 0; gq < 4; ++gq) { u32x2 w;
                const unsigned w0 = otp[(16 * s + 8 * dt + 2 * gq) * 512], w1 = otp[(16 * s + 8 * dt + 2 * gq + 1) * 512];
                w.x = pg8::cvt_pk_bf16(__uint_as_float(w0 << 16) + f * o[s][dt][4 * gq], __uint_as_float(w0 & 0xffff0000u) + f * o[s][dt][4 * gq + 1]);
                w.y = pg8::cvt_pk_bf16(__uint_as_float(w1 << 16) + f * o[s][dt][4 * gq + 2], __uint_as_float(w1 & 0xffff0000u) + f * o[s][dt][4 * gq + 3]);
                *(u32x2*)(orow + 32 * dt + 8 * gq) = w; }
    }
#undef N2_LOAD_TILE
}
__device__ __forceinline__ void phase_nsa2(const KArgs& a, int l, LAS unsigned char* lds, int wave, int lane) {
    const float gq = wave_max(fabsf(a.in[I_QN][l * 64 + lane])), gk = wave_max(fabsf(a.in[I_KN][l * 64 + lane]));
    const float shiftc = __uint_as_float(__builtin_amdgcn_readfirstlane(__float_as_uint(fmaxf(0.f, 64.f * 0.125f * LOG2E * gq * gk - 60.f))));
    for (int it = blockIdx.x; it < NB * 2 * 16; it += gridDim.x) {
        const int k = it >> 8, pos = it & 255, grp = pos >> 6, bg = pos & 63;
        const int T = 15 - (4 * k + ((k & 1) ? 3 - grp : grp));
        nsa2_item(a, l, bg >> 1, bg & 1, T, lds, wave, lane, shiftc);
    }
}

constexpr int R_Q = 0, R_K = 18432, R_V = 36864, R_ST = 61440;
__device__ __forceinline__ void ret_mfma_item(const KArgs& a, int l, int bh, LAS unsigned char* lds, int wave, int lane_in) {
    int lane = lane_in; asm volatile("" : "+v"(lane));
    const int tid = wave * 64 + lane, b = bh >> 2, h = bh & 3;
    const float l2g = (h == 0) ? -0.04580368961312479f : (h == 1) ? -0.02272007650008353f : (h == 2) ? -0.011315313227834146f : -0.005646563141142062f;
    const float gamma = 1.0f - exp2f(-5.0f - (float)h), g127 = exp2f(127.f * l2g), g128 = exp2f(128.f * l2g);
    const bf16_t* Z = (const bf16_t*)(a.ws + WS_Z);
    const float* cs = (const float*)(a.ws + WS_CS);
    const int sc_ = tid >> 2, part = tid & 3, d0 = 16 * part;
    const float dq = exp2f((float)sc_ * l2g), dk = 0.125f * exp2f(-(float)sc_ * l2g);
    __syncthreads();
    for (int e = tid; e < 576; e += NTHREADS) *(LAS u32x4*)(lds + R_ST + e * 16) = (u32x4){0u, 0u, 0u, 0u};
    u32x4 qraw[2], kraw[2], vraw[2]; f32x4 csv[4];
#define RET_PREFETCH(n) do { const size_t pos_ = (size_t)(n) * 128 + sc_; const bf16_t* zr_ = Z + ((size_t)b * SEQ + pos_) * ZW + h * 64 + d0; \
        qraw[0] = *(const u32x4*)(zr_ + ZC_RQ); qraw[1] = *(const u32x4*)(zr_ + ZC_RQ + 8); kraw[0] = *(const u32x4*)(zr_ + ZC_RK); kraw[1] = *(const u32x4*)(zr_ + ZC_RK + 8); \
        vraw[0] = *(const u32x4*)(zr_ + ZC_RV); vraw[1] = *(const u32x4*)(zr_ + ZC_RV + 8); \
        const f32x4* cp_ = (const f32x4*)(cs + (pos_ * 32 + 8 * part) * 2); csv[0] = cp_[0]; csv[1] = cp_[1]; csv[2] = cp_[2]; csv[3] = cp_[3]; } while (0)
    RET_PREFETCH(0);
    f32x16 sacc = (f32x16){};
    const int cl = lane & 31, hi = lane >> 5;
    for (int n = 0; n < SEQ / 128; ++n) {
        {
            u32x4 qo[2], ko[2];
#pragma unroll
            for (int w = 0; w < 8; ++w) {
                const unsigned qw = qraw[w >> 2][w & 3], kw = kraw[w >> 2][w & 3];
                const float cv = csv[w >> 1][(w & 1) * 2], sv = csv[w >> 1][(w & 1) * 2 + 1];
                const float q0 = bf2f(qw & 0xffff), q1 = bf2f(qw >> 16), k0 = bf2f(kw & 0xffff), k1 = bf2f(kw >> 16);
                qo[w >> 2][w & 3] = pg8::cvt_pk_bf16((q0 * cv - q1 * sv) * dq, (q1 * cv + q0 * sv) * dq);
                ko[w >> 2][w & 3] = pg8::cvt_pk_bf16((k0 * cv - k1 * sv) * dk, (k1 * cv + k0 * sv) * dk);
            }
            *(LAS u32x4*)(lds + R_Q + sc_ * KST + d0 * 2) = qo[0]; *(LAS u32x4*)(lds + R_Q + sc_ * KST + d0 * 2 + 16) = qo[1];
            *(LAS u32x4*)(lds + R_K + sc_ * KST + d0 * 2) = ko[0]; *(LAS u32x4*)(lds + R_K + sc_ * KST + d0 * 2 + 16) = ko[1];
            *(LAS u32x4*)(lds + R_V + sc_ * VST + d0 * 2) = vraw[0]; *(LAS u32x4*)(lds + R_V + sc_ * VST + d0 * 2 + 16) = vraw[1];
        }
        __syncthreads();
        if (n + 1 < SEQ / 128) RET_PREFETCH(n + 1);
        const LAS unsigned char* stc = lds + R_ST + (n & 1) * 9216; LAS unsigned char* stn = lds + R_ST + ((n + 1) & 1) * 9216;
        if (wave < 4) {
            const int qc = wave;
            const size_t row = (size_t)b * SEQ + (size_t)n * 128 + 32 * qc + cl;
            u32x2 ggv[8];
            { const bf16_t* grow = Z + row * ZW + ZC_RG + h * 64 + 4 * hi;
#pragma unroll
              for (int i = 0; i < 8; ++i) ggv[i] = *(const u32x2*)(grow + 32 * (i >> 2) + 8 * (i & 3)); }
            bf16x8 qf[4];
#pragma unroll
            for (int ks = 0; ks < 4; ++ks) qf[ks] = *(const LAS bf16x8*)(lds + R_Q + (32 * qc + cl) * KST + (16 * ks + 8 * hi) * 2);
            f32x16 o[2];
#pragma unroll
            for (int et = 0; et < 2; ++et) { f32x16 x = (f32x16){};
#pragma unroll
                for (int ks = 0; ks < 4; ++ks) { const bf16x8 af = *(const LAS bf16x8*)(stc + (32 * et + cl) * KST + (16 * ks + 8 * hi) * 2); x = __builtin_amdgcn_mfma_f32_32x32x16_bf16(af, qf[ks], x, 0, 0, 0); }
#pragma unroll
                for (int r = 0; r < 16; ++r) o[et][r] = gamma * x[r]; }
            for (int mt = 0; mt <= qc; ++mt) {
                f32x16 p = (f32x16){};
#pragma unroll
                for (int ks = 0; ks < 4; ++ks) { const bf16x8 af = *(const LAS bf16x8*)(lds + R_K + (32 * mt + cl) * KST + (16 * ks + 8 * hi) * 2); p = __builtin_amdgcn_mfma_f32_32x32x16_bf16(af, qf[ks], p, 0, 0, 0); }
                if (mt == qc) {
#pragma unroll
                    for (int r = 0; r < 16; ++r) p[r] = (crow(r, hi) <= cl) ? p[r] : 0.f; }
                const LAS unsigned char* vt_ = lds + R_V + 32 * mt * VST;
                pv_step(o, vt_, 0, pack8(p, 0), lane); pv_step(o, vt_, 1, pack8(p, 8), lane);
            }
            float ss = 0.f;
#pragma unroll
            for (int et = 0; et < 2; ++et)
#pragma unroll
                for (int r = 0; r < 16; ++r) ss += o[et][r] * o[et][r];
            ss += __shfl_xor(ss, 32);
            const float rstd = rsqrtf(ss * (1.f / 64.f) + EPS);
            bf16_t* orow = (bf16_t*)(a.ws + WS_MIX) + row * DM + h * 64 + 4 * hi;
#pragma unroll
            for (int et = 0; et < 2; ++et)
#pragma unroll
                for (int gq = 0; gq < 4; ++gq) {
                    const u32x2 gg = ggv[et * 4 + gq];
                    const float ga = bf2f(gg.x & 0xffff), gb = bf2f(gg.x >> 16), gc = bf2f(gg.y & 0xffff), gd = bf2f(gg.y >> 16);
                    u32x2 w;
                    w.x = pg8::cvt_pk_bf16(ga / (1.f + __expf(-ga)) * o[et][4 * gq] * rstd, gb / (1.f + __expf(-gb)) * o[et][4 * gq + 1] * rstd);
                    w.y = pg8::cvt_pk_bf16(gc / (1.f + __expf(-gc)) * o[et][4 * gq + 2] * rstd, gd / (1.f + __expf(-gd)) * o[et][4 * gq + 3] * rstd);
                    if (n + qc + cl != 0) *(u32x2*)(orow + 32 * et + 8 * gq) = w;
                }
        } else {
            const int w4 = wave - 4, et = w4 >> 1, dt = w4 & 1, i = lane & 15, dh = (lane >> 4) & 1;
            f32x16 nw = (f32x16){};
            const LAS unsigned char* pv = lds + R_V + (4 * hi + (i >> 2)) * VST + (32 * et + 16 * dh + 4 * (i & 3)) * 2;
            const LAS unsigned char* pk = lds + R_K + (4 * hi + (i >> 2)) * KST + (32 * dt + 16 * dh + 4 * (i & 3)) * 2;
#pragma unroll
            for (int s8 = 0; s8 < 8; ++s8) {
                const s16x4 al = tr_read(pv + 16 * s8 * VST), ah = tr_read(pv + (16 * s8 + 8) * VST);
                const s16x4 bl = tr_read(pk + 16 * s8 * KST), bh2 = tr_read(pk + (16 * s8 + 8) * KST);
                const bf16x8 af = (bf16x8){al[0], al[1], al[2], al[3], ah[0], ah[1], ah[2], ah[3]}, bfr = (bf16x8){bl[0], bl[1], bl[2], bl[3], bh2[0], bh2[1], bh2[2], bh2[3]};
                nw = __builtin_amdgcn_mfma_f32_32x32x16_bf16(af, bfr, nw, 0, 0, 0);
            }
#pragma unroll
            for (int r = 0; r < 16; ++r) { sacc[r] = g128 * sacc[r] + g127 * nw[r];
                *(LAS bf16_t*)(stn + (32 * et + crow(r, hi)) * KST + (32 * dt + cl) * 2) = (bf16_t)f2bf(sacc[r]); }
        }
        __syncthreads();
    }
#undef RET_PREFETCH
}

constexpr size_t WS_KV = 864 * MiB;
__device__ __forceinline__ float ret_l2g(int h) { return (h == 0) ? -0.04580368961312479f : (h == 1) ? -0.02272007650008353f : (h == 2) ? -0.011315313227834146f : -0.005646563141142062f; }
struct RetRaw { u32x4 q[2], k[2], v[2]; f32x4 cs[4]; };
template <bool WITH_Q> __device__ __forceinline__ void ret_load_chunk(const KArgs& a, int b, int h, int n, int tid, RetRaw& R) {
    const bf16_t* Z = (const bf16_t*)(a.ws + WS_Z); const float* cs = (const float*)(a.ws + WS_CS);
    const int sc_ = tid >> 2, part = tid & 3, d0 = 16 * part;
    const size_t pos = (size_t)n * 128 + sc_; const bf16_t* zr = Z + ((size_t)b * SEQ + pos) * ZW + h * 64 + d0;
    if (WITH_Q) { R.q[0] = *(const u32x4*)(zr + ZC_RQ); R.q[1] = *(const u32x4*)(zr + ZC_RQ + 8); }
    R.k[0] = *(const u32x4*)(zr + ZC_RK); R.k[1] = *(const u32x4*)(zr + ZC_RK + 8); R.v[0] = *(const u32x4*)(zr + ZC_RV); R.v[1] = *(const u32x4*)(zr + ZC_RV + 8);
    const f32x4* cp = (const f32x4*)(cs + (pos * 32 + 8 * part) * 2); R.cs[0] = cp[0]; R.cs[1] = cp[1]; R.cs[2] = cp[2]; R.cs[3] = cp[3];
}
template <bool WITH_Q> __device__ __forceinline__ void ret_store_chunk(const RetRaw& R, int h, LAS unsigned char* lds, int tid) {
    const float l2g = ret_l2g(h);
    const int sc_ = tid >> 2, part = tid & 3, d0 = 16 * part;
    const float dq = exp2f((float)sc_ * l2g), dk = 0.125f * exp2f(-(float)sc_ * l2g);
    u32x4 qo[2], ko[2];
#pragma unroll
    for (int w = 0; w < 8; ++w) {
        const float cv = R.cs[w >> 1][(w & 1) * 2], sv = R.cs[w >> 1][(w & 1) * 2 + 1];
        const unsigned kw = R.k[w >> 2][w & 3]; const float k0 = bf2f(kw & 0xffff), k1 = bf2f(kw >> 16);
        ko[w >> 2][w & 3] = pg8::cvt_pk_bf16((k0 * cv - k1 * sv) * dk, (k1 * cv + k0 * sv) * dk);
        if (WITH_Q) { const unsigned qw = R.q[w >> 2][w & 3]; const float q0 = bf2f(qw & 0xffff), q1 = bf2f(qw >> 16);
            qo[w >> 2][w & 3] = pg8::cvt_pk_bf16((q0 * cv - q1 * sv) * dq, (q1 * cv + q0 * sv) * dq); }
    }
    if (WITH_Q) { *(LAS u32x4*)(lds + R_Q + sc_ * KST + d0 * 2) = qo[0]; *(LAS u32x4*)(lds + R_Q + sc_ * KST + d0 * 2 + 16) = qo[1]; }
    *(LAS u32x4*)(lds + R_K + sc_ * KST + d0 * 2) = ko[0]; *(LAS u32x4*)(lds + R_K + sc_ * KST + d0 * 2 + 16) = ko[1];
    *(LAS u32x4*)(lds + R_V + sc_ * VST + d0 * 2) = R.v[0]; *(LAS u32x4*)(lds + R_V + sc_ * VST + d0 * 2 + 16) = R.v[1];
}
__device__ __forceinline__ void retkv_item(const KArgs& a, int l, int item, int next_item, RetRaw& R, LAS unsigned char* lds, int wave, int lane_in) {
    int lane = lane_in; asm volatile("" : "+v"(lane));
    const int tid = wave * 64 + lane, n = item & 15, bh = item >> 4, h = bh & 3;
    __syncthreads();
    ret_store_chunk<false>(R, h, lds, tid);
    if (next_item >= 0) ret_load_chunk<false>(a, (next_item >> 4) >> 2, (next_item >> 4) & 3, next_item & 15, tid, R);
    __syncthreads();
    if (wave < 4) {
        const int et = wave >> 1, dt = wave & 1, i = lane & 15, dh = (lane >> 4) & 1, hi = lane >> 5, cl = lane & 31;
        f32x16 nw = (f32x16){};
        const LAS unsigned char* pv = lds + R_V + (4 * hi + (i >> 2)) * VST + (32 * et + 16 * dh + 4 * (i & 3)) * 2;
        const LAS unsigned char* pk = lds + R_K + (4 * hi + (i >> 2)) * KST + (32 * dt + 16 * dh + 4 * (i & 3)) * 2;
#pragma unroll
        for (int s8 = 0; s8 < 8; ++s8) {
            const s16x4 al = tr_read(pv + 16 * s8 * VST), ah = tr_read(pv + (16 * s8 + 8) * VST);
            const s16x4 bl = tr_read(pk + 16 * s8 * KST), bh2 = tr_read(pk + (16 * s8 + 8) * KST);
            const bf16x8 af = (bf16x8){al[0], al[1], al[2], al[3], ah[0], ah[1], ah[2], ah[3]}, bfr = (bf16x8){bl[0], bl[1], bl[2], bl[3], bh2[0], bh2[1], bh2[2], bh2[3]};
            nw = __builtin_amdgcn_mfma_f32_32x32x16_bf16(af, bfr, nw, 0, 0, 0);
        }
        float* kv = (float*)(a.ws + WS_KV) + (size_t)item * 4096;
#pragma unroll
        for (int r = 0; r < 16; ++r) kv[(32 * et + crow(r, hi)) * 64 + 32 * dt + cl] = nw[r];
    }
}
__device__ __forceinline__ void retout_item(const KArgs& a, int l, int item, int next_item, RetRaw& R, LAS unsigned char* lds, int wave, int lane_in) {
    int lane = lane_in; asm volatile("" : "+v"(lane));
    const int tid = wave * 64 + lane, n = item & 15, bh = item >> 4, b = bh >> 2, h = bh & 3;
    const float l2g = ret_l2g(h), gamma = 1.0f - exp2f(-5.0f - (float)h);
    const bf16_t* Z = (const bf16_t*)(a.ws + WS_Z);
    __syncthreads();
    {
        const int e = tid >> 3, d8 = (tid & 7) * 8;
        f32x4 s0 = (f32x4){0.f, 0.f, 0.f, 0.f}, s1 = s0;
        const float* kvb = (const float*)(a.ws + WS_KV) + (size_t)(bh * 16) * 4096 + e * 64 + d8;
#pragma unroll 5
        for (int j = 0; j < n; ++j) { const float cf = exp2f(l2g * (float)(128 * (n - 1 - j) + 127));
            const f32x4 x0 = *(const f32x4*)(kvb + (size_t)j * 4096), x1 = *(const f32x4*)(kvb + (size_t)j * 4096 + 4); s0 += cf * x0; s1 += cf * x1; }
        u32x4 w; w.x = pg8::cvt_pk_bf16(s0[0], s0[1]); w.y = pg8::cvt_pk_bf16(s0[2], s0[3]); w.z = pg8::cvt_pk_bf16(s1[0], s1[1]); w.w = pg8::cvt_pk_bf16(s1[2], s1[3]);
        *(LAS u32x4*)(lds + R_ST + e * KST + d8 * 2) = w;
    }
    ret_store_chunk<true>(R, h, lds, tid);
    if (next_item >= 0) ret_load_chunk<true>(a, (next_item >> 4) >> 2, (next_item >> 4) & 3, next_item & 15, tid, R);
    __syncthreads();
    if (wave < 4) {
        const int qc = wave, cl = lane & 31, hi = lane >> 5;
        const LAS unsigned char* stc = lds + R_ST;
        const size_t row = (size_t)b * SEQ + (size_t)n * 128 + 32 * qc + cl;
        u32x2 ggv[8];
        { const bf16_t* grow = Z + row * ZW + ZC_RG + h * 64 + 4 * hi;
#pragma unroll
          for (int i = 0; i < 8; ++i) ggv[i] = *(const u32x2*)(grow + 32 * (i >> 2) + 8 * (i & 3)); }
        bf16x8 qf[4];
#pragma unroll
        for (int ks = 0; ks < 4; ++ks) qf[ks] = *(const LAS bf16x8*)(lds + R_Q + (32 * qc + cl) * KST + (16 * ks + 8 * hi) * 2);
        f32x16 o[2];
#pragma unroll
        for (int et = 0; et < 2; ++et) { f32x16 x = (f32x16){};
#pragma unroll
            for (int ks = 0; ks < 4; ++ks) { const bf16x8 af = *(const LAS bf16x8*)(stc + (32 * et + cl) * KST + (16 * ks + 8 * hi) * 2); x = __builtin_amdgcn_mfma_f32_32x32x16_bf16(af, qf[ks], x, 0, 0, 0); }
#pragma unroll
            for (int r = 0; r < 16; ++r) o[et][r] = gamma * x[r]; }
        for (int mt = 0; mt <= qc; ++mt) {
            f32x16 p = (f32x16){};
#pragma unroll
            for (int ks = 0; ks < 4; ++ks) { const bf16x8 af = *(const LAS bf16x8*)(lds + R_K + (32 * mt + cl) * KST + (16 * ks + 8 * hi) * 2); p = __builtin_amdgcn_mfma_f32_32x32x16_bf16(af, qf[ks], p, 0, 0, 0); }
            if (mt == qc) {
#pragma unroll
                for (int r = 0; r < 16; ++r) p[r] = (crow(r, hi) <= cl) ? p[r] : 0.f; }
            const LAS unsigned char* vt_ = lds + R_V + 32 * mt * VST;
            pv_step(o, vt_, 0, pack8(p, 0), lane); pv_step(o, vt_, 1, pack8(p, 8), lane);
        }
        float ss = 0.f;
#pragma unroll
        for (int et = 0; et < 2; ++et)
#pragma unroll
            for (int r = 0; r < 16; ++r) ss += o[et][r] * o[et][r];
        ss += __shfl_xor(ss, 32);
        const float rstd = rsqrtf(ss * (1.f / 64.f) + EPS);
        bf16_t* orow = (bf16_t*)(a.ws + WS_MIX) + row * DM + h * 64 + 4 * hi;
#pragma unroll
        for (int et = 0; et < 2; ++et)
#pragma unroll
            for (int gq = 0; gq < 4; ++gq) {
                const u32x2 gg = ggv[et * 4 + gq];
                const float ga = bf2f(gg.x & 0xffff), gb = bf2f(gg.x >> 16), gc = bf2f(gg.y & 0xffff), gd = bf2f(gg.y >> 16);
                u32x2 w;
#define SILU_F(x) ((x) * __builtin_amdgcn_rcpf(1.f + __builtin_amdgcn_exp2f(-LOG2E * (x))))
                w.x = pg8::cvt_pk_bf16(SILU_F(ga) * o[et][4 * gq] * rstd, SILU_F(gb) * o[et][4 * gq + 1] * rstd);
                w.y = pg8::cvt_pk_bf16(SILU_F(gc) * o[et][4 * gq + 2] * rstd, SILU_F(gd) * o[et][4 * gq + 3] * rstd);
#undef SILU_F
                if (n + qc + cl != 0) *(u32x2*)(orow + 32 * et + 8 * gq) = w;
            }
    }
}

__device__ __forceinline__ void cmp_mfma_item(const KArgs& a, int l, int item, LAS unsigned char* lds, int wave, int lane_in) {
    int lane = lane_in; asm volatile("" : "+v"(lane));
    const int tid = wave * 64 + lane, kv = item & 1, g = (item >> 1) & 1, b = item >> 2;
    const bf16_t* Z = (const bf16_t*)(a.ws + WS_Z);
    const bf16_t* w1t = (const bf16_t*)(a.ws + WS_W1T) + (size_t)((l * 2 + kv) * 128) * 1024;
    const float* w2 = a.in[kv ? I_W2V : I_W2K] + (size_t)l * 64 * 64;
    const float* cb = (const float*)(a.ws + WS_CB) + (l * 2 + kv) * 64;
    LAS float* Y = (LAS float*)lds;
    LAS float* o1 = Y + 128 * 132;
    LAS float* w2s = o1 + 128 * 64;
    __syncthreads();
    for (int e = tid; e < 1024; e += NTHREADS) *(LAS f32x4*)(w2s + e * 4) = *(const f32x4*)(w2 + e * 4);
    {
        const int mt = wave >> 1, ct0 = (wave & 1) * 2, r = lane & 31, hi = lane >> 5;
        const bf16_t* abase = Z + ((size_t)b * SEQ + 16 * (32 * mt + r)) * ZW + (kv ? ZC_VC : ZC_KC) + g * 64 + 8 * hi;
        const bf16_t* bb0 = w1t + (size_t)(32 * ct0 + r) * 1024 + 8 * hi; const bf16_t* bb1 = bb0 + 32 * 1024;
        f32x16 acc0 = (f32x16){}, acc1 = (f32x16){};
#pragma unroll 8
        for (int ks = 0; ks < 64; ++ks) {
            const bf16x8 af = *(const bf16x8*)(abase + (size_t)(ks >> 2) * ZW + (ks & 3) * 16);
            const bf16x8 b0 = *(const bf16x8*)(bb0 + 16 * ks), b1 = *(const bf16x8*)(bb1 + 16 * ks);
            acc0 = __builtin_amdgcn_mfma_f32_32x32x16_bf16(af, b0, acc0, 0, 0, 0); acc1 = __builtin_amdgcn_mfma_f32_32x32x16_bf16(af, b1, acc1, 0, 0, 0);
        }
#pragma unroll
        for (int rr = 0; rr < 16; ++rr) { const int m = 32 * mt + crow(rr, hi); Y[m * 132 + 32 * ct0 + r] = acc0[rr]; Y[m * 132 + 32 * (ct0 + 1) + r] = acc1[rr]; }
    }
    __syncthreads();
    for (int e = tid; e < 128 * 64; e += NTHREADS) { const int n = e >> 6, j = e & 63;
        float sv = 0.f; if (n < 127) { sv = Y[n * 132 + j] + Y[(n + 1) * 132 + 64 + j] + cb[j]; sv = sv / (1.f + __expf(-sv)); }
        o1[e] = sv; }
    __syncthreads();
    {
        const int n = tid >> 2, jq = (tid & 3) * 16;
        float acc[16];
#pragma unroll
        for (int i = 0; i < 16; ++i) acc[i] = 0.f;
        for (int j = 0; j < 64; ++j) { const float x = o1[n * 64 + j];
#pragma unroll
            for (int q = 0; q < 4; ++q) { const f32x4 w = *(const LAS f32x4*)(w2s + j * 64 + jq + 4 * q); acc[4 * q] += x * w[0]; acc[4 * q + 1] += x * w[1]; acc[4 * q + 2] += x * w[2]; acc[4 * q + 3] += x * w[3]; } }
        if (!kv) { float ss = 0.f;
#pragma unroll
            for (int i = 0; i < 16; ++i) ss += acc[i] * acc[i];
            ss += __shfl_xor(ss, 1); ss += __shfl_xor(ss, 2);
            const float rstd = rsqrtf(ss * (1.f / 64.f) + EPS);
#pragma unroll
            for (int i = 0; i < 16; ++i) acc[i] = acc[i] * rstd * a.in[I_KN][l * 64 + jq + i]; }
        bf16_t* dst = (bf16_t*)(a.ws + (kv ? WS_VCMP : WS_KCMP)) + ((size_t)((b * 2 + g) * 128) + n) * 64 + jq;
        u32x4 w0, w1v;
        w0.x = pk2(acc[0], acc[1]); w0.y = pk2(acc[2], acc[3]); w0.z = pk2(acc[4], acc[5]); w0.w = pk2(acc[6], acc[7]);
        w1v.x = pk2(acc[8], acc[9]); w1v.y = pk2(acc[10], acc[11]); w1v.z = pk2(acc[12], acc[13]); w1v.w = pk2(acc[14], acc[15]);
        if (n >= 127) { w0 = (u32x4){0u, 0u, 0u, 0u}; w1v = w0; }
        *(u32x4*)dst = w0; *(u32x4*)(dst + 8) = w1v;
    }
}

__device__ __forceinline__ void ret0_item(const KArgs& a, int l, int item, LAS unsigned char* lds, int wave, int lane) {
    int tid = threadIdx.x; asm volatile("" : "+v"(tid));
    const int b = item >> 2, hh = item & 3;
    const float* xrow = ((l == 0) ? a.in[I_X] : a.out) + (size_t)b * SEQ * DM;
    const float* gain = a.in[I_NORM_MIX] + l * DM;
    const float* W = a.in[I_W_IN] + (size_t)l * DM * INW;
    LAS float* hs = (LAS float*)lds;
    LAS float* red = hs + 1024;
    LAS float* qk = red + 16;
    __syncthreads();
    float ss = 0.f;
    for (int k = tid; k < DM; k += NTHREADS) { const float xv = xrow[k]; ss += xv * xv; hs[k] = xv * gain[k]; }
    ss = wave_sum(ss);
    if (lane == 0) red[wave] = ss;
    __syncthreads();
    float tot = 0.f;
#pragma unroll
    for (int w = 0; w < 8; ++w) tot += red[w];
    const float rstd = rsqrtf(tot * (1.f / DM) + EPS);
    const int d = tid & 63, which = (tid >> 6) & 1, kp = tid >> 7;
    const float* wc = W + (size_t)(kp * 256) * INW + (which ? ZC_RK : ZC_RQ) + hh * 64 + d;
    float acc0 = 0.f, acc1 = 0.f, acc2 = 0.f, acc3 = 0.f;
    for (int k = 0; k < 256; k += 32) {
        float wv[32];
#pragma unroll
        for (int i = 0; i < 32; ++i) wv[i] = wc[(size_t)(k + i) * INW];
#pragma unroll
        for (int i = 0; i < 32; i += 4) { acc0 += hs[kp * 256 + k + i] * wv[i]; acc1 += hs[kp * 256 + k + i + 1] * wv[i + 1]; acc2 += hs[kp * 256 + k + i + 2] * wv[i + 2]; acc3 += hs[kp * 256 + k + i + 3] * wv[i + 3]; }
    }
    qk[tid] = ((acc0 + acc1) + (acc2 + acc3)) * rstd;
    __syncthreads();
    if (wave == 0) {
        const float q0 = (qk[lane] + qk[128 + lane]) + (qk[256 + lane] + qk[384 + lane]), k0 = (qk[64 + lane] + qk[192 + lane]) + (qk[320 + lane] + qk[448 + lane]);
        const float sdot = wave_sum(q0 * k0) * 0.125f;
        const bf16_t* Z = (const bf16_t*)(a.ws + WS_Z);
        const size_t row = (size_t)b * SEQ;
        const float v = bf2f(Z[row * ZW + ZC_RV + hh * 64 + lane]), g = bf2f(Z[row * ZW + ZC_RG + hh * 64 + lane]);
        const float o = sdot * v;
        const float ro = rsqrtf(wave_sum(o * o) * (1.f / 64.f) + EPS);
        ((bf16_t*)(a.ws + WS_MIX))[row * DM + hh * 64 + lane] = (bf16_t)f2bf(g / (1.f + __expf(-g)) * o * ro);
    }
}

constexpr int N_RET = 128, N_CMP = 128, N_CONV = 256, N_KN = 256, N_R0 = 128;
#ifndef RET_MFMA
#define RET_MFMA 1
#endif
constexpr int N_RKV = 2048, N_ROUT = 2048;
__device__ __forceinline__ int ret_item_of(int i) {
    if (gridDim.x != 256) { const int bh = i >> 4; return (bh << 4) | (((i & 15) + 2 * (bh >> 4)) & 15); }
    const int blk = i & 255, k = i >> 8, x = blk & 7, slot = blk >> 3;
    const int q = 2 * k + (slot >> 4), n = ((slot & 15) + 2 * k) & 15, bh = x + 8 * q;
    return (bh << 4) | n;
}
__device__ __forceinline__ void phase_mix1(const KArgs& a, int l, LAS unsigned char* lds, int wave, int lane, int ci) {
    {
        RetRaw R; const int tid0 = wave * 64 + lane;
        int i = blockIdx.x;
        if (i < N_RKV) { const int it = ret_item_of(i); ret_load_chunk<false>(a, (it >> 4) >> 2, (it >> 4) & 3, it & 15, tid0, R); }
        for (; i < N_RKV; i += gridDim.x) { const int nx = i + gridDim.x; retkv_item(a, l, ret_item_of(i), nx < N_RKV ? ret_item_of(nx) : -1, R, lds, wave, lane); }
    }
    unsigned* ctr = (unsigned*)a.ws + ci;
    LAS int* slot = (LAS int*)(lds + LDS_BYTES - 16);
    for (;;) {
        __syncthreads();
        if (threadIdx.x == 0) *slot = (int)atomicAdd(ctr, 1u);
        __syncthreads();
        int r = *slot;
        if (r >= N_R0 + N_CMP + N_CONV + N_KN) break;
        if (r < N_R0) { ret0_item(a, l, r, lds, wave, lane); continue; } r -= N_R0;
        if (r < N_CMP) { cmp_mfma_item(a, l, r, lds, wave, lane); continue; } r -= N_CMP;
        if (r < N_CONV) { conv_item(a, l, r); continue; } r -= N_CONV;
        knorm_item(a, l, r, wave, lane);
    }
}
__device__ __forceinline__ void phase_retout(const KArgs& a, int l, LAS unsigned char* lds, int wave, int lane, int ci) {
    (void)ci;
    RetRaw R; const int tid0 = wave * 64 + lane;
    int i = blockIdx.x;
    if (i < N_ROUT) { const int it = ret_item_of(i); ret_load_chunk<true>(a, (it >> 4) >> 2, (it >> 4) & 3, it & 15, tid0, R); }
    for (; i < N_ROUT; i += gridDim.x) { const int nx = i + gridDim.x; retout_item(a, l, ret_item_of(i), nx < N_ROUT ? ret_item_of(nx) : -1, R, lds, wave, lane); }
}

#define XB_TMO      128
#define XB_XCNT(j)  (256  + 64 * (j))
#define XB_XSUB(j)  (1280 + 64 * (j))
#define XB_XGEN(j)  (2304 + 64 * (j))
#define XB_TOP      3328
#define XB_TOPGEN   3392
#define XCD_BAR_WORDS 3456
#define XB_SPIN_CAP (1u << 18)
constexpr size_t WS_BAR = 65536;
__device__ __forceinline__ unsigned xb_ld(unsigned* p)              { return __hip_atomic_load(p, __ATOMIC_RELAXED, __HIP_MEMORY_SCOPE_AGENT); }
__device__ __forceinline__ unsigned xb_add(unsigned* p, unsigned v) { return __hip_atomic_fetch_add(p, v, __ATOMIC_RELAXED, __HIP_MEMORY_SCOPE_AGENT); }
__device__ __forceinline__ unsigned xb_xcc_id() { return (unsigned)__builtin_amdgcn_s_getreg((3 << 11) | 20) & 0xFu; }
#define XB_SPIN(cond, bar) do { unsigned _sp = 0; while (cond) { __builtin_amdgcn_s_sleep(1); \
    if ((++_sp & 255u) == 0u) { if (xb_ld(&(bar)[XB_TMO])) break; if (_sp > XB_SPIN_CAP) { atomicAdd(&(bar)[XB_TMO], 1u); break; } } } } while (0)
struct XcdBarrier { unsigned* bar; unsigned x; volatile LAS unsigned* st; };
__device__ __forceinline__ XcdBarrier xcd_barrier_post(unsigned* bar, volatile LAS unsigned* st) {
    XcdBarrier b; b.bar = bar; b.x = xb_xcc_id(); b.st = st;
    if (threadIdx.x == 0) (void)xb_add(&bar[XB_XCNT(b.x)], 1u);
    return b;
}
__device__ __forceinline__ void xcd_barrier_complete(unsigned* bar, unsigned x, unsigned& nloc, unsigned& nx) {
    const unsigned G = gridDim.x * gridDim.y * gridDim.z;
    unsigned sum, cnt, mine, sp = 0u;
    for (;;) {
        sum = 0u; cnt = 0u; mine = 0u;
#pragma unroll
        for (unsigned j = 0; j < 16; ++j) { const unsigned c = xb_ld(&bar[XB_XCNT(j)]); sum += c; cnt += (c > 0u) ? 1u : 0u; mine = (j == x) ? c : mine; }
        if (sum == G) break;
        __builtin_amdgcn_s_sleep(1);
        if ((++sp & 255u) == 0u) { if (xb_ld(&bar[XB_TMO])) break; if (sp > XB_SPIN_CAP) { atomicAdd(&bar[XB_TMO], 1u); break; } }
    }
    nloc = mine > 0u ? mine : 1u; nx = cnt > 0u ? cnt : 1u;
}
__device__ __forceinline__ void xcd_barrier(const XcdBarrier& b) {
    asm volatile("s_waitcnt vmcnt(0)" ::: "memory");
    __syncthreads();
    if (threadIdx.x == 0) {
        unsigned* bar = b.bar;
        __builtin_amdgcn_s_waitcnt(0);
        unsigned nloc = b.st[0], nx = b.st[1];
        if (nloc == 0u) { xcd_barrier_complete(bar, b.x, nloc, nx); b.st[0] = nloc; b.st[1] = nx; }
        const unsigned old = xb_add(&bar[XB_XSUB(b.x)], 1u);
        const unsigned gen = old / nloc;
        if (old + 1u == (gen + 1u) * nloc) {
            __builtin_amdgcn_fence(__ATOMIC_RELEASE, "agent");
            asm volatile("s_waitcnt vmcnt(0)" ::: "memory");
            const unsigned og = xb_add(&bar[XB_TOP], 1u);
            const unsigned tg = og / nx;
            if (og + 1u == (tg + 1u) * nx) xb_add(&bar[XB_TOPGEN], 1u);
            else XB_SPIN(xb_ld(&bar[XB_TOPGEN]) == tg, bar);
            __builtin_amdgcn_fence(__ATOMIC_ACQUIRE, "agent");
            xb_add(&bar[XB_XGEN(b.x)], 1u);
            asm volatile("s_waitcnt vmcnt(0)" ::: "memory");
        } else {
            XB_SPIN(xb_ld(&bar[XB_XGEN(b.x)]) == gen, bar);
            __builtin_amdgcn_fence(__ATOMIC_ACQUIRE, "agent");
            asm volatile("s_waitcnt vmcnt(0)" ::: "memory");
        }
    }
    __syncthreads();
}

constexpr int N_PHASES = 1 + 6 * DEPTH;
#ifndef NSA_MFMA
#define NSA_MFMA 1
#endif

#define PH_IN(k) (lo <= (k) && (k) < hi)
#define PH_SEAM(k) do { if (PH_IN(k) && PH_IN((k) + 1)) { xcd_barrier(xbar); if (PROBE & 16) xcd_barrier(xbar); } } while (0)
#define PH_TID() int tid = threadIdx.x; asm volatile("" : "+v"(tid)); const int lane = tid & 63, wave = __builtin_amdgcn_readfirstlane(tid >> 6); (void)lane; (void)wave
template <int L> __device__ __forceinline__ void layer_phases(const KArgs& a, LAS unsigned char* lds, const XcdBarrier& xbar, int lo, int hi) {
    unsigned char* ws = a.ws;
    bf16_t* XB = (bf16_t*)(ws + WS_XN); bf16_t* Zb = (bf16_t*)(ws + WS_Z); bf16_t* Hb = (bf16_t*)(ws + WS_H); bf16_t* MIXb = (bf16_t*)(ws + WS_MIX); float* SSQ = (float*)(ws + WS_SSQ);
    const int G = gridDim.x; constexpr int l = L, P0 = 1 + 6 * L;
    const float* xcur = (l == 0) ? a.in[I_X] : a.out;
    if (PH_IN(P0 + 0)) {
        pg8::Gemm g{XB, (const bf16_t*)(ws + WS_WIN) + (size_t)l * ZW * DM, MTOK, ZW, DM}; pg8::StaticOrder S; S.init(MTOK, ZW, G, (int)blockIdx.x);
        pg8::EpiBf16<0> E{Zb, ZW, SSQ};
        pg8::gemm_phase<pg8::EpiBf16<0>, pg8::StaticOrder, true, true>(lds, g, S, E);
    }
    PH_SEAM(P0 + 0);
    if (PH_IN(P0 + 1)) { PH_TID(); phase_mix1(a, l, lds, wave, lane, l); }
    PH_SEAM(P0 + 1);
    if (PH_IN(P0 + 2)) { PH_TID(); phase_nsa2(a, l, lds, wave, lane); phase_retout(a, l, lds, wave, lane, 4 + l); }
    PH_SEAM(P0 + 2);
    if (PH_IN(P0 + 3)) {
        pg8::Gemm g{MIXb, (const bf16_t*)(ws + WS_WOUT) + (size_t)l * DM * DM, MTOK, DM, DM}; pg8::StaticOrder S; S.init(MTOK, DM, G, (int)blockIdx.x);
        pg8::EpiRes E{xcur, a.out, DM, XB, SSQ};
        pg8::gemm_phase<pg8::EpiRes, pg8::StaticOrder, true, true>(lds, g, S, E);
    }
    PH_SEAM(P0 + 3);
    if (PH_IN(P0 + 4)) {
        pg8::Gemm g{XB, (const bf16_t*)(ws + WS_WUP) + (size_t)l * FF * DM, MTOK, FF, DM}; pg8::StaticOrder S; S.init(MTOK, FF, G, (int)blockIdx.x);
        pg8::EpiBf16<1> E{Hb, FF, SSQ};
        pg8::gemm_phase<pg8::EpiBf16<1>, pg8::StaticOrder, true, true>(lds, g, S, E);
    }
    PH_SEAM(P0 + 4);
    if (PH_IN(P0 + 5)) {
        pg8::Gemm g{Hb, (const bf16_t*)(ws + WS_WDN) + (size_t)l * DM * FF, MTOK, DM, FF}; pg8::StaticOrder S; S.init(MTOK, DM, G, (int)blockIdx.x);
        pg8::EpiRes E{a.out, a.out, DM, (l + 1 < DEPTH) ? XB : nullptr, SSQ};
        pg8::gemm_phase<pg8::EpiRes, pg8::StaticOrder, true, true>(lds, g, S, E);
    }
    PH_SEAM(P0 + 5);
}
__global__ void __launch_bounds__(NTHREADS, 2) fwd_kernel(KArgs a) {
    extern __shared__ __attribute__((aligned(16))) unsigned char lds_raw[];
    LAS unsigned char* lds = (LAS unsigned char*)lds_raw;
    cg::grid_group grid = cg::this_grid();
    const int lo = a.ph_lo, hi = a.ph_hi;
    volatile LAS unsigned* xst = (volatile LAS unsigned*)(lds + LDS_BYTES - 32);
    if (threadIdx.x < 2) xst[threadIdx.x] = 0u;
    unsigned* barw = (unsigned*)(a.ws + WS_BAR);
    {
        PH_TID();
        if (blockIdx.x == 0) {
            if (tid < 64) ((unsigned*)a.ws)[tid] = 0u;
            for (int e = tid; e < XCD_BAR_WORDS; e += NTHREADS) barw[e] = 0u;
        }
        phase_prologue(a, lds, wave, lane);
        if (PROBE & 32) phase_prologue(a, lds, wave, lane);
        phase_xcvt(a.in[I_X], (bf16_t*)(a.ws + WS_XN), (float*)(a.ws + WS_SSQ), wave, lane);
    }
    __syncthreads(); grid.sync();
    const XcdBarrier xbar = xcd_barrier_post(barw, xst);
    layer_phases<0>(a, lds, xbar, lo, hi);
    layer_phases<1>(a, lds, xbar, lo, hi);
}

extern "C" void kernel_launch(void* const* d_in, const int* in_sizes, int n_in, void* d_out, int out_size, void* d_ws, size_t ws_size, hipStream_t stream) {
    static int grid = 0;
    if (grid == 0) {
        if (n_in != 16 || in_sizes[0] != MTOK * DM || out_size != MTOK * DM || ws_size < WS_END) {
            fprintf(stderr, "kernel_launch: unexpected shapes (n_in %d, in0 %d, out %d, ws %zu)\n", n_in, n_in > 0 ? in_sizes[0] : -1, out_size, ws_size); grid = -1; return; }
        int dev = 0, cus = 0, per_cu = 0;
        hipGetDevice(&dev); hipDeviceGetAttribute(&cus, hipDeviceAttributeMultiprocessorCount, dev);
        hipFuncSetAttribute((const void*)fwd_kernel, hipFuncAttributeMaxDynamicSharedMemorySize, LDS_BYTES);
        hipOccupancyMaxActiveBlocksPerMultiprocessor(&per_cu, (const void*)fwd_kernel, NTHREADS, LDS_BYTES);
        if (per_cu < 1) { fprintf(stderr, "kernel_launch: occupancy query says %d blocks per CU\n", per_cu); per_cu = 1; }
        (void)hipGetLastError();
        grid = cus * 1;
    }
    if (grid < 0) return;
    KArgs a{};
    for (int i = 0; i < 16; ++i) a.in[i] = (const float*)d_in[i];
    a.out = (float*)d_out; a.ws = (unsigned char*)d_ws; a.ph_lo = 0; a.ph_hi = N_PHASES;
    void* args[] = {&a};
    hipError_t e = hipLaunchCooperativeKernel((const void*)fwd_kernel, dim3(grid), dim3(NTHREADS), args, LDS_BYTES, stream);
    if (e != hipSuccess) fprintf(stderr, "cooperative launch failed: %s (grid %d)\n", hipGetErrorString(e), grid);
}
```

```cpp
#include <hip/hip_runtime.h>
#include <hip/hip_cooperative_groups.h>
#include <cstdio>
#include <cstdint>
namespace cg = cooperative_groups;

#define LAS __attribute__((address_space(3)))
typedef unsigned short bf16_t;
typedef short bf16x8 __attribute__((ext_vector_type(8)));
typedef float f32x4 __attribute__((ext_vector_type(4)));
typedef unsigned u32x4 __attribute__((ext_vector_type(4)));
typedef unsigned u32x2 __attribute__((ext_vector_type(2)));

template <int K> __device__ __forceinline__ float swz_f(float v) { return __builtin_bit_cast(float, __builtin_amdgcn_ds_swizzle(__builtin_bit_cast(int, v), (K << 10) | 0x1f)); }
template <int K> __device__ __forceinline__ unsigned swz_u(unsigned v) { return (unsigned)__builtin_amdgcn_ds_swizzle((int)v, (K << 10) | 0x1f); }
__device__ __forceinline__ float x32_sum(float v) { const auto rr = __builtin_amdgcn_permlane32_swap(__float_as_uint(v), __float_as_uint(v), false, false); return __uint_as_float(rr[0]) + __uint_as_float(rr[1]); }
__device__ __forceinline__ float x32_max(float v) { const auto rr = __builtin_amdgcn_permlane32_swap(__float_as_uint(v), __float_as_uint(v), false, false); return fmaxf(__uint_as_float(rr[0]), __uint_as_float(rr[1])); }
__device__ __forceinline__ unsigned x32_or(unsigned v) { const auto rr = __builtin_amdgcn_permlane32_swap(v, v, false, false); return rr[0] | rr[1]; }
namespace pg8 {
#define PG8_LAS __attribute__((address_space(3)))
constexpr int BM = 256, BK = 64, HALF = 128, HTB = HALF * BK * 2, STAGE_BYTES = 8 * HTB, NXCD = 8, WGM = 8;
__host__ __device__ __forceinline__ int lds_byte(int r, int c) { const int st = (r >> 4) * 2 + (c >> 5), rr = r & 15, cc = c & 31, ob = rr * 64 + cc * 2; return st * 1024 + (ob ^ (((ob >> 9) & 1) << 5)); }
__host__ __device__ __forceinline__ void stage_rc(int b, int& R, int& C) { const int st = b / 1024, sb = b % 1024, swz = sb ^ (((sb >> 9) & 1) << 5); R = (st >> 1) * 16 + swz / 64; C = (st & 1) * 32 + (swz % 64) / 2; }
__host__ __device__ __forceinline__ int perm32(int rho) { const int n = rho >> 4, i = rho & 15; return 8 * (i >> 2) + 4 * n + (i & 3); }
struct Unit { int pm, pn; };
struct Gemm { const bf16_t* A; const bf16_t* Bt; int M, N, K; };
struct StaticOrder {
    int nM, nN, nwg, G, c;
    __host__ __device__ void init(int M, int N, int G_, int c_) { nM = M / BM; nN = N / BM; nwg = nM * nN; G = G_; c = c_; }
    __host__ __device__ bool next(int i, Unit& u) const {
        const long L = (long)i * G + c; if (L >= nwg) return false;
        int wgid = (int)L; { const int q = nwg / NXCD, r = nwg % NXCD, xcd = wgid % NXCD, off = wgid / NXCD; wgid = (xcd < r ? xcd * (q + 1) : r * (q + 1) + (xcd - r) * q) + off; }
        const int nig = WGM * nN, gid = wgid / nig, fm = gid * WGM, gsz = (nM - fm) < WGM ? (nM - fm) : WGM;
        u.pm = fm + ((wgid % nig) % gsz); u.pn = (wgid % nig) / gsz; return true;
    }
    __device__ __forceinline__ void a_ready(const Unit&) const {}
    __device__ __forceinline__ void done(const Unit&) const {}
};
typedef float f32x2_t __attribute__((ext_vector_type(2))); typedef __bf16 bf16x2_t __attribute__((ext_vector_type(2)));
__device__ __forceinline__ unsigned cvt_pk_bf16(float lo, float hi) { const f32x2_t v = {lo, hi}; const bf16x2_t b = __builtin_convertvector(v, bf16x2_t); return __builtin_bit_cast(unsigned, b); }

template <int ACT> struct EpiBf16 {
    static constexpr bool PERM = true, AFTER_DRAIN = false, HAS_PRE = true;
    bf16_t* O; int ldc; const float* ssq;
    struct Pre { f32x4 s0, s1, s2, s3; };
    __device__ __forceinline__ Pre pre_load(int pm, int tid) const { Pre p; const f32x4* sp = (const f32x4*)(ssq + (size_t)(pm * BM + (tid & 255)) * 16); p.s0 = sp[0]; p.s1 = sp[1]; p.s2 = sp[2]; p.s3 = sp[3]; return p; }
    __device__ __forceinline__ void pre_store(const Pre& p, PG8_LAS float* tab, int tid) const {
        const float tot = ((p.s0[0] + p.s0[1]) + (p.s0[2] + p.s0[3])) + ((p.s1[0] + p.s1[1]) + (p.s1[2] + p.s1[3])) + ((p.s2[0] + p.s2[1]) + (p.s2[2] + p.s2[3])) + ((p.s3[0] + p.s3[1]) + (p.s3[2] + p.s3[3]));
        if (tid < 256) tab[tid] = rsqrtf(tot * (1.0f / 1024.0f) + 1e-6f);
    }
    __device__ __forceinline__ void operator()(const f32x4 (&acc)[2][2][4][2], const Unit& u, int wr, int wc, int fr, int fq, const PG8_LAS float* tab) const {
        const int rl0 = wr * 64 + fr; const int row0 = u.pm * BM + rl0; const int col0 = u.pn * BM + wc * 32 + 8 * fq;
#pragma unroll
        for (int ai = 0; ai < 2; ++ai)
#pragma unroll
            for (int m = 0; m < 4; ++m) { const int row = row0 + ai * HALF + m * 16; bf16_t* rowp = O + (size_t)row * ldc + col0;
                const float rstd = tab[rl0 + ai * HALF + m * 16];
#pragma unroll
                for (int bj = 0; bj < 2; ++bj) { f32x4 v0 = acc[ai][bj][m][0] * rstd, v1 = acc[ai][bj][m][1] * rstd;
                    if (ACT == 1) {
#pragma unroll
                        for (int e = 0; e < 4; ++e) { float a = v0[e] > 0.f ? v0[e] : 0.f; v0[e] = a * a; float b = v1[e] > 0.f ? v1[e] : 0.f; v1[e] = b * b; } }
                    u32x4 w; w.x = cvt_pk_bf16(v0[0], v0[1]); w.y = cvt_pk_bf16(v0[2], v0[3]); w.z = cvt_pk_bf16(v1[0], v1[1]); w.w = cvt_pk_bf16(v1[2], v1[3]);
                    *(u32x4*)(rowp + bj * HALF) = w; } }
    }
};
struct EpiRes {
    static constexpr bool PERM = true, AFTER_DRAIN = false, HAS_PRE = false;
    const float* base; float* out; int ldc; bf16_t* xb; float* ssq;
    __device__ __forceinline__ void operator()(const f32x4 (&acc)[2][2][4][2], const Unit& u, int wr, int wc, int fr, int fq, const PG8_LAS float*) const {
        const int row0 = u.pm * BM + wr * 64 + fr; const int col0 = u.pn * BM + wc * 32 + 8 * fq;
#pragma unroll
        for (int ai = 0; ai < 2; ++ai)
#pragma unroll
            for (int m = 0; m < 4; ++m) { const int row = row0 + ai * HALF + m * 16; const size_t off = (size_t)row * ldc + col0; float ss = 0.f;
#pragma unroll
                for (int bj = 0; bj < 2; ++bj) {
                    const f32x4 b0 = *(const f32x4*)(base + off + bj * HALF), b1 = *(const f32x4*)(base + off + bj * HALF + 4);
                    const f32x4 v0 = b0 + acc[ai][bj][m][0], v1 = b1 + acc[ai][bj][m][1];
                    *(f32x4*)(out + off + bj * HALF) = v0; *(f32x4*)(out + off + bj * HALF + 4) = v1;
                    if (xb) { u32x4 w; w.x = cvt_pk_bf16(v0[0], v0[1]); w.y = cvt_pk_bf16(v0[2], v0[3]); w.z = cvt_pk_bf16(v1[0], v1[1]); w.w = cvt_pk_bf16(v1[2], v1[3]);
                        *(u32x4*)(xb + off + bj * HALF) = w;
                        ss += ((v0[0] * v0[0] + v0[1] * v0[1]) + (v0[2] * v0[2] + v0[3] * v0[3])) + ((v1[0] * v1[0] + v1[1] * v1[1]) + (v1[2] * v1[2] + v1[3] * v1[3])); } }
                if (xb) { ss += __shfl_xor(ss, 16); ss += __shfl_xor(ss, 32); if (fq == 0) ssq[(size_t)row * 16 + u.pn * 4 + wc] = ss; } }
    }
};

template <class Epi, class Sched, bool ALIGN_EPI = false, bool SP2 = false>
__device__ __forceinline__ void gemm_phase(PG8_LAS unsigned char* lds, const Gemm g, const Sched& S, const Epi& E) {
    int tid_ = threadIdx.x; asm volatile("" : "+v"(tid_));
    const int tid = tid_, wid = __builtin_amdgcn_readfirstlane(tid >> 6), lane = tid & 63, wr = wid >> 2, wc = wid & 3, fr = lane & 15, fq = lane >> 4;
    const int K = g.K, nt = K / BK;
    unsigned voffA[2], voffB[2];
#pragma unroll
    for (int i = 0; i < 2; ++i) { int R, C; stage_rc(tid * 16 + i * 8192, R, C); const int Rb = Epi::PERM ? ((R & ~31) + perm32(R & 31)) : R;
        voffA[i] = (unsigned)(R * K + C) * 2u; voffB[i] = (unsigned)(Rb * K + C) * 2u; }
    const size_t kstep = (size_t)(BK * 2);
    const size_t hstep = (size_t)HALF * K * 2;
    const size_t tstep = 2 * hstep;
    const unsigned ldsw = (unsigned)wid * 1024u;
    const int aoff = lds_byte(wr * 64 + fr, fq * 8), boff = lds_byte(wc * 32 + fr, fq * 8);
#define PG8_SA(b, h) (((b) * 2 + (h)) * HTB)
#define PG8_SB(b, h) ((4 + (b) * 2 + (h)) * HTB)
#define PG8_STAGE(bufoff, gbase, voff) do { _Pragma("unroll") for (int _i = 0; _i < 2; ++_i) \
        __builtin_amdgcn_global_load_lds((const unsigned*)((const char*)(gbase) + (voff)[_i]), (PG8_LAS unsigned*)(lds + (bufoff) + ldsw + _i * 8192), 16, 0, 0); } while (0)
#define PG8_LDA(dst, b, h) do { _Pragma("unroll") for (int m = 0; m < 4; ++m) _Pragma("unroll") for (int k = 0; k < 2; ++k) dst[m][k] = *(const PG8_LAS bf16x8*)(lds + PG8_SA(b, h) + aoff + m * 2048 + k * 1024); } while (0)
#define PG8_LDB(dst, b, h) do { _Pragma("unroll") for (int n = 0; n < 2; ++n) _Pragma("unroll") for (int k = 0; k < 2; ++k) dst[n][k] = *(const PG8_LAS bf16x8*)(lds + PG8_SB(b, h) + boff + n * 2048 + k * 1024); } while (0)
#define PG8_MMA(ai, bj, At, Bt) do { __builtin_amdgcn_s_setprio(1); _Pragma("unroll") for (int m = 0; m < 4; ++m) _Pragma("unroll") for (int n = 0; n < 2; ++n) _Pragma("unroll") for (int k = 0; k < 2; ++k) \
        acc[ai][bj][m][n] = __builtin_amdgcn_mfma_f32_16x16x32_bf16(Bt[n][k], At[m][k], acc[ai][bj][m][n], 0, 0, 0); __builtin_amdgcn_s_setprio(0); } while (0)
#define PG8_WAIT_V(n) asm volatile("s_waitcnt vmcnt(" #n ")" ::: "memory")
#define PG8_WAIT_L(n) asm volatile("s_waitcnt lgkmcnt(" #n ")" ::: "memory")
#define PG8_BAR __builtin_amdgcn_s_barrier()
#define PG8_SCHED __builtin_amdgcn_sched_barrier(0)
    Unit cur, nxt; int ui = 0;
    if (!S.next(0, cur)) return;
    f32x4 acc[2][2][4][2];
#pragma unroll
    for (int a = 0; a < 2; ++a)
#pragma unroll
        for (int b = 0; b < 2; ++b)
#pragma unroll
            for (int m = 0; m < 4; ++m)
#pragma unroll
                for (int n = 0; n < 2; ++n) acc[a][b][m][n] = (f32x4){0.f, 0.f, 0.f, 0.f};
    bf16x8 At[4][2], B0[2][2], B1[2][2];
    const char* cA = (const char*)g.A + (size_t)cur.pm * tstep; const char* cB = (const char*)g.Bt + (size_t)cur.pn * tstep;
    S.a_ready(cur);
    PG8_LAS float* ptab = (PG8_LAS float*)(lds + STAGE_BYTES);
    if constexpr (Epi::HAS_PRE) { const auto p0 = E.pre_load(cur.pm, tid); E.pre_store(p0, ptab, tid); }
    if constexpr (SP2) {
        PG8_STAGE(PG8_SB(0, 0), cB, voffB); PG8_STAGE(PG8_SB(0, 1), cB + hstep, voffB); PG8_STAGE(PG8_SA(0, 0), cA, voffA); PG8_STAGE(PG8_SA(0, 1), cA + hstep, voffA);
        if (wr == 1) PG8_BAR;
        PG8_WAIT_V(2); PG8_BAR;
        PG8_STAGE(PG8_SB(1, 0), cB + kstep, voffB); PG8_STAGE(PG8_SA(1, 0), cA + kstep, voffA); PG8_STAGE(PG8_SB(1, 1), cB + hstep + kstep, voffB);
        PG8_WAIT_V(6); PG8_BAR;
    } else {
        PG8_STAGE(PG8_SB(0, 0), cB, voffB); PG8_STAGE(PG8_SA(0, 0), cA, voffA); PG8_STAGE(PG8_SB(0, 1), cB + hstep, voffB); PG8_STAGE(PG8_SA(0, 1), cA + hstep, voffA);
        if (wr == 1) PG8_BAR;
        PG8_WAIT_V(4); PG8_BAR;
        PG8_STAGE(PG8_SB(1, 0), cB + kstep, voffB); PG8_STAGE(PG8_SA(1, 0), cA + kstep, voffA); PG8_STAGE(PG8_SB(1, 1), cB + hstep + kstep, voffB);
        PG8_WAIT_V(6); PG8_BAR;
    }
    for (;;) {
        const bool has_next = S.next(ui + 1, nxt);
        const char* nA = has_next ? (const char*)g.A + (size_t)nxt.pm * tstep : cA; const char* nB = has_next ? (const char*)g.Bt + (size_t)nxt.pn * tstep : cB;
        for (int t = 0; t < nt; t += 2) {
            const bool last = (t == nt - 2);
            const char* a1 = cA + (size_t)(t + 1) * kstep;
            const char* a2 = last ? nA : cA + (size_t)(t + 2) * kstep; const char* b2 = last ? nB : cB + (size_t)(t + 2) * kstep;
            const char* a3 = a2 + kstep; const char* b3 = b2 + kstep;
            if (last && has_next) S.a_ready(nxt);
            if constexpr (SP2) {
            PG8_LDB(B0, 0, 0); PG8_LDB(B1, 0, 1); PG8_SCHED; PG8_LDA(At, 0, 0); PG8_STAGE(PG8_SA(1, 1), a1 + hstep, voffA);
            PG8_WAIT_V(8); PG8_WAIT_L(0); PG8_BAR; PG8_MMA(0, 0, At, B0); PG8_MMA(0, 1, At, B1); PG8_BAR; PG8_SCHED;
            PG8_LDA(At, 0, 1); PG8_STAGE(PG8_SB(0, 0), b2, voffB); PG8_STAGE(PG8_SB(0, 1), b2 + hstep, voffB); PG8_STAGE(PG8_SA(0, 0), a2, voffA);
            PG8_WAIT_V(8); PG8_WAIT_L(0); PG8_BAR; PG8_MMA(1, 0, At, B0); PG8_MMA(1, 1, At, B1); PG8_BAR; PG8_SCHED;
            PG8_LDB(B0, 1, 0); PG8_LDB(B1, 1, 1); PG8_SCHED; PG8_LDA(At, 1, 0); PG8_STAGE(PG8_SA(0, 1), a2 + hstep, voffA);
            PG8_WAIT_V(8); PG8_WAIT_L(0); PG8_BAR; PG8_MMA(0, 0, At, B0); PG8_MMA(0, 1, At, B1); PG8_BAR; PG8_SCHED;
            PG8_LDA(At, 1, 1); PG8_STAGE(PG8_SB(1, 0), b3, voffB); PG8_STAGE(PG8_SB(1, 1), b3 + hstep, voffB); PG8_STAGE(PG8_SA(1, 0), a3, voffA);
            PG8_WAIT_V(8); PG8_WAIT_L(0); PG8_BAR; PG8_MMA(1, 0, At, B0); PG8_MMA(1, 1, At, B1); PG8_BAR; PG8_SCHED;
            } else {
            PG8_LDB(B0, 0, 0); PG8_SCHED; PG8_LDA(At, 0, 0); PG8_STAGE(PG8_SA(1, 1), a1 + hstep, voffA);
            PG8_WAIT_L(8); PG8_BAR; PG8_WAIT_L(0); PG8_MMA(0, 0, At, B0); PG8_BAR; PG8_SCHED;
            PG8_LDB(B1, 0, 1); PG8_STAGE(PG8_SB(0, 0), b2, voffB);
            PG8_BAR; PG8_WAIT_L(0); PG8_MMA(0, 1, At, B1); PG8_BAR;
            PG8_LDA(At, 0, 1); PG8_STAGE(PG8_SA(0, 0), a2, voffA);
            PG8_BAR; PG8_WAIT_L(0); PG8_MMA(1, 0, At, B0); PG8_BAR; PG8_SCHED;
            PG8_STAGE(PG8_SB(0, 1), b2 + hstep, voffB);
            PG8_WAIT_V(6); PG8_BAR; PG8_MMA(1, 1, At, B1); PG8_BAR;
            PG8_LDB(B0, 1, 0); PG8_SCHED; PG8_LDA(At, 1, 0); PG8_STAGE(PG8_SA(0, 1), a2 + hstep, voffA);
            PG8_WAIT_L(8); PG8_BAR; PG8_WAIT_L(0); PG8_MMA(0, 0, At, B0); PG8_BAR; PG8_SCHED;
            PG8_LDB(B1, 1, 1); PG8_STAGE(PG8_SB(1, 0), b3, voffB);
            PG8_BAR; PG8_WAIT_L(0); PG8_MMA(0, 1, At, B1); PG8_BAR;
            PG8_LDA(At, 1, 1); PG8_STAGE(PG8_SA(1, 0), a3, voffA);
            PG8_BAR; PG8_WAIT_L(0); PG8_MMA(1, 0, At, B0); PG8_BAR; PG8_SCHED;
            PG8_STAGE(PG8_SB(1, 1), b3 + hstep, voffB);
            PG8_WAIT_V(6); PG8_BAR; PG8_MMA(1, 1, At, B1); PG8_BAR;
            }
        }
        if constexpr (ALIGN_EPI) { if (wr == 0) PG8_BAR; }
        if constexpr (Epi::HAS_PRE) {
            if (has_next) { const auto pn_ = E.pre_load(nxt.pm, tid); E(acc, cur, wr, wc, fr, fq, ptab + (ui & 1) * 256); E.pre_store(pn_, ptab + ((ui + 1) & 1) * 256, tid); }
            else E(acc, cur, wr, wc, fr, fq, ptab + (ui & 1) * 256);
        } else { E(acc, cur, wr, wc, fr, fq, ptab); }
        S.done(cur);
        if (!has_next) break;
#pragma unroll
        for (int a = 0; a < 2; ++a)
#pragma unroll
            for (int b = 0; b < 2; ++b)
#pragma unroll
                for (int m = 0; m < 4; ++m)
#pragma unroll
                    for (int n = 0; n < 2; ++n) acc[a][b][m][n] = (f32x4){0.f, 0.f, 0.f, 0.f};
        cur = nxt; cA = nA; cB = nB; ++ui;
        if constexpr (ALIGN_EPI) { if (wr == 1) PG8_BAR; }
    }
    PG8_WAIT_V(0);
    if constexpr (!ALIGN_EPI) { if (wr == 0) PG8_BAR; }
    PG8_BAR;
#undef PG8_SA
#undef PG8_SB
#undef PG8_STAGE
#undef PG8_LDA
#undef PG8_LDB
#undef PG8_MMA
#undef PG8_WAIT_V
#undef PG8_WAIT_L
#undef PG8_BAR
#undef PG8_SCHED
}
}

#ifndef PROBE
#define PROBE 0
#endif
constexpr int NB = 32, SEQ = 2048, DM = 1024, MTOK = NB * SEQ, INW = 3096, ZW = 3328, FF = 4096, DEPTH = 2;
constexpr int ZC_RQ = 0, ZC_RK = 256, ZC_RV = 512, ZC_RG = 768, ZC_CB = 1024, ZC_CC = 1280, ZC_CH = 1536, ZC_NQ = 1792,
              ZC_KC = 2304, ZC_VC = 2432, ZC_KS = 2560, ZC_VS = 2688, ZC_KW = 2816, ZC_VW = 2944, ZC_NG = 3072;
constexpr float EPS = 1e-6f, LOG2E = 1.4426950408889634f;
constexpr size_t MiB = 1u << 20;
constexpr size_t WS_WIN = 1 * MiB, WS_WOUT = 14 * MiB, WS_WUP = 18 * MiB, WS_WDN = 34 * MiB, WS_CS = 50 * MiB, WS_KCMP = 51 * MiB, WS_VCMP = 52 * MiB,
                 WS_KSN = 53 * MiB, WS_KWN = 69 * MiB, WS_SSQ = 86 * MiB, WS_W1T = 90 * MiB, WS_CB = 91 * MiB, WS_XN = 96 * MiB, WS_Z = 224 * MiB, WS_H = 224 * MiB, WS_MIX = 736 * MiB, WS_END = 896 * MiB;
constexpr int LDS_BYTES = 139264;
constexpr int NWAVES = 8, NTHREADS = 512;

struct KArgs { const float* in[16]; float* out; unsigned char* ws; int ph_lo, ph_hi; };
enum { I_X = 0, I_NORM_MIX, I_W_IN, I_CONV_W, I_QN, I_KN, I_PEK, I_W1K, I_W2K, I_PEV, I_W1V, I_W2V, I_W_OUT, I_NORM_MLP, I_W_UP, I_W_DOWN };

__device__ __forceinline__ float bf2f(unsigned short u) { return __uint_as_float((unsigned)u << 16); }
__device__ __forceinline__ unsigned f2bf(float f) { unsigned u = __float_as_uint(f); return (u + 0x7fffu + ((u >> 16) & 1u)) >> 16; }
__device__ __forceinline__ unsigned pk2(float lo, float hi) { return f2bf(lo) | (f2bf(hi) << 16); }
__device__ __forceinline__ float wave_sum(float v) {
#pragma unroll
    for (int o = 1; o < 64; o <<= 1) v += __shfl_xor(v, o);
    return v;
}
__device__ __forceinline__ float wave_max(float v) {
#pragma unroll
    for (int o = 1; o < 64; o <<= 1) v = fmaxf(v, __shfl_xor(v, o));
    return v;
}
#define LDS_FENCE() asm volatile("s_waitcnt lgkmcnt(0)" ::: "memory")

__device__ __forceinline__ void transpose_item(const float* W, int K, int N, int Npad, bf16_t* WT, LAS float* scr, int item, int lane, const float* gain) {
    const int nblk = Npad / 32, kb = item / nblk, nb = item % nblk, k0 = 64 * kb, n0 = 32 * nb;
#pragma unroll
    for (int i = 0; i < 8; ++i) { const int q = i * 64 + lane, kk = q >> 3, c4 = (q & 7) * 4; const int n = n0 + c4;
        f32x4 v = (f32x4){0.f, 0.f, 0.f, 0.f};
        if (n < N) v = *(const f32x4*)(W + (size_t)(k0 + kk) * N + n);
        const float gsc = gain ? gain[k0 + kk] : 1.f;
        scr[kk * 33 + c4] = v[0] * gsc; scr[kk * 33 + c4 + 1] = v[1] * gsc; scr[kk * 33 + c4 + 2] = v[2] * gsc; scr[kk * 33 + c4 + 3] = v[3] * gsc; }
    LDS_FENCE();
    const int c = lane & 7;
#pragma unroll
    for (int j = 0; j < 4; ++j) { const int nn = (lane >> 3) + 8 * j; const LAS float* s = scr + (8 * c) * 33 + nn;
        u32x4 o; o.x = pk2(s[0 * 33], s[1 * 33]); o.y = pk2(s[2 * 33], s[3 * 33]); o.z = pk2(s[4 * 33], s[5 * 33]); o.w = pk2(s[6 * 33], s[7 * 33]);
        *(u32x4*)(WT + (size_t)(n0 + nn) * K + k0 + 8 * c) = o; }
    LDS_FENCE();
}

__device__ __forceinline__ void phase_prologue(const KArgs& a, LAS unsigned char* lds, int wave, int lane) {
    LAS float* scr = (LAS float*)(lds + wave * 16384);
    const int gw = blockIdx.x * NWAVES + wave, NGW = gridDim.x * NWAVES;
    constexpr int I_IN = (DM / 64) * (ZW / 32), I_OUT = (DM / 64) * (DM / 32), I_UP = (DM / 64) * (FF / 32), I_DN = (FF / 64) * (DM / 32);
    constexpr int PER_L = I_IN + I_OUT + I_UP + I_DN;
    for (int it = gw; it < DEPTH * PER_L; it += NGW) {
        const int l = it / PER_L; int r = it % PER_L;
        if (r < I_IN) { transpose_item(a.in[I_W_IN] + (size_t)l * DM * INW, DM, INW, ZW, (bf16_t*)(a.ws + WS_WIN) + (size_t)l * ZW * DM, scr, r, lane, a.in[I_NORM_MIX] + l * DM); continue; } r -= I_IN;
        if (r < I_OUT) { transpose_item(a.in[I_W_OUT] + (size_t)l * DM * DM, DM, DM, DM, (bf16_t*)(a.ws + WS_WOUT) + (size_t)l * DM * DM, scr, r, lane, nullptr); continue; } r -= I_OUT;
        if (r < I_UP) { transpose_item(a.in[I_W_UP] + (size_t)l * DM * FF, DM, FF, FF, (bf16_t*)(a.ws + WS_WUP) + (size_t)l * FF * DM, scr, r, lane, a.in[I_NORM_MLP] + l * DM); continue; } r -= I_UP;
        transpose_item(a.in[I_W_DOWN] + (size_t)l * FF * DM, FF, DM, DM, (bf16_t*)(a.ws + WS_WDN) + (size_t)l * DM * FF, scr, r, lane, nullptr);
    }
    for (int e = blockIdx.x * NTHREADS + threadIdx.x; e < DEPTH * 2 * 128 * 128; e += gridDim.x * NTHREADS) {
        const int k8 = e & 127, col = (e >> 7) & 127, lk = e >> 14, l = lk >> 1, kv = lk & 1;
        const int a2 = col >> 6, j = col & 63, k = k8 * 8, lp = k >> 6, d = k & 63;
        const float* src = a.in[kv ? I_W1V : I_W1K] + ((size_t)l * 2048 + (size_t)((16 * a2 + lp) * 64 + d)) * 64 + j;
        u32x4 w; w.x = pk2(src[0], src[64]); w.y = pk2(src[128], src[192]); w.z = pk2(src[256], src[320]); w.w = pk2(src[384], src[448]);
        *(u32x4*)((bf16_t*)(a.ws + WS_W1T) + ((size_t)lk * 128 + col) * 1024 + k) = w;
    }
    if (blockIdx.x < 4) {
        const int lk = blockIdx.x, l = lk >> 1, kv = lk & 1, j = lane;
        const float* pe = a.in[kv ? I_PEV : I_PEK] + (size_t)l * 2048; const float* w1 = a.in[kv ? I_W1V : I_W1K] + (size_t)l * 2048 * 64;
        float s = 0.f;
        for (int k = wave * 256; k < wave * 256 + 256; ++k) s += pe[k] * w1[(size_t)k * 64 + j];
        LAS float* red = (LAS float*)(lds + 131072);
        red[wave * 64 + lane] = s;
        __syncthreads();
        if (wave == 0) { float t = 0.f;
#pragma unroll
            for (int w = 0; w < 8; ++w) t += red[w * 64 + lane];
            ((float*)(a.ws + WS_CB))[lk * 64 + j] = t; }
    }
    float2* cs = (float2*)(a.ws + WS_CS);
    for (int e = blockIdx.x * NTHREADS + threadIdx.x; e < SEQ * 32; e += gridDim.x * NTHREADS) {
        const int pos = e >> 5, i = e & 31;
        const float inv_freq = exp2f(-(float)i * 0.42863588321127255f);
        const float ang = (float)pos * inv_freq;
        const double rev = (double)ang * 0.15915494309189535;
        const float fr = (float)(rev - floor(rev));
        cs[e] = make_float2(__builtin_amdgcn_cosf(fr), __builtin_amdgcn_sinf(fr));
    }
}

__device__ __forceinline__ void phase_norm(const float* x, const float* gain, bf16_t* xn, float* rs, int wave, int lane) {
    const int gw = blockIdx.x * NWAVES + wave, NGW = gridDim.x * NWAVES;
    f32x4 gv[4];
#pragma unroll
    for (int j = 0; j < 4; ++j) gv[j] = *((const f32x4*)gain + 64 * j + lane);
    for (int m = gw; m < MTOK; m += NGW) {
        const f32x4* xr = (const f32x4*)(x + (size_t)m * DM) + lane;
        f32x4 v[4]; float s = 0.f;
#pragma unroll
        for (int j = 0; j < 4; ++j) { v[j] = xr[64 * j]; s += (v[j].x * v[j].x + v[j].y * v[j].y) + (v[j].z * v[j].z + v[j].w * v[j].w); }
        const float rstd = rsqrtf(wave_sum(s) * (1.f / DM) + EPS);
        float hm = 0.f;
#pragma unroll
        for (int j = 0; j < 4; ++j) { v[j] = v[j] * rstd * gv[j]; hm = fmaxf(hm, fmaxf(fmaxf(fabsf(v[j].x), fabsf(v[j].y)), fmaxf(fabsf(v[j].z), fabsf(v[j].w)))); }
        hm = wave_max(hm);
        const float sc = (hm > 0.f) ? bf2f((unsigned short)f2bf(hm)) / hm : 1.f;
        u32x2* o8 = (u32x2*)(xn + (size_t)m * DM) + lane;
#pragma unroll
        for (int j = 0; j < 4; ++j) { u32x2 w; w.x = pk2(v[j].x * sc, v[j].y * sc); w.y = pk2(v[j].z * sc, v[j].w * sc); o8[64 * j] = w; }
        if (lane == 0) rs[m] = 1.f / sc;
    }
}

__device__ __forceinline__ void phase_xcvt(const float* x, bf16_t* xb, float* ssq, int wave, int lane) {
    const int gw = blockIdx.x * NWAVES + wave, NGW = gridDim.x * NWAVES;
    for (int m = gw; m < MTOK; m += NGW) {
        const f32x4* xr = (const f32x4*)(x + (size_t)m * DM) + lane;
        f32x4 v[4]; float s = 0.f;
#pragma unroll
        for (int j = 0; j < 4; ++j) { v[j] = xr[64 * j]; s += (v[j].x * v[j].x + v[j].y * v[j].y) + (v[j].z * v[j].z + v[j].w * v[j].w); }
        s = wave_sum(s);
        u32x2* o8 = (u32x2*)(xb + (size_t)m * DM) + lane;
#pragma unroll
        for (int j = 0; j < 4; ++j) { u32x2 w; w.x = pk2(v[j].x, v[j].y); w.y = pk2(v[j].z, v[j].w); o8[64 * j] = w; }
        if (lane < 16) ssq[(size_t)m * 16 + lane] = (lane == 0) ? s : 0.f;
    }
}

__device__ __forceinline__ void ret_item(const KArgs& a, int l, int bh, LAS unsigned char* lds, int wave, int lane) {
    int tid = threadIdx.x; asm volatile("" : "+v"(tid));
    const int b = bh >> 2, h = bh & 3;
    const float gamma = 1.0f - exp2f(-5.0f - (float)h);
    const bf16_t* Z = (const bf16_t*)(a.ws + WS_Z);
    bf16_t* MIX = (bf16_t*)(a.ws + WS_MIX);
    const float2* cs = (const float2*)(a.ws + WS_CS);
    LAS float* qs = (LAS float*)lds; LAS float* ks = qs + 32 * 64; LAS float* vs = ks + 32 * 64; LAS float* op = vs + 32 * 64;
    float S[8];
#pragma unroll
    for (int i = 0; i < 8; ++i) S[i] = 0.f;
    for (int tb = 0; tb < SEQ / 32; ++tb) {
#pragma unroll
        for (int r = 0; r < 2; ++r) {
            const int p = tid + r * NTHREADS, tt = p >> 5, i = p & 31, pos = tb * 32 + tt;
            const bf16_t* zr = Z + (size_t)(b * SEQ + pos) * ZW + h * 64 + 2 * i;
            const unsigned qq = *(const unsigned*)(zr + ZC_RQ), kk = *(const unsigned*)(zr + ZC_RK), vv = *(const unsigned*)(zr + ZC_RV);
            const float2 c = cs[pos * 32 + i];
            const float q0 = bf2f(qq & 0xffff), q1 = bf2f(qq >> 16), k0 = bf2f(kk & 0xffff), k1 = bf2f(kk >> 16);
            qs[tt * 64 + 2 * i] = q0 * c.x - q1 * c.y; qs[tt * 64 + 2 * i + 1] = q1 * c.x + q0 * c.y;
            ks[tt * 64 + 2 * i] = (k0 * c.x - k1 * c.y) * 0.125f; ks[tt * 64 + 2 * i + 1] = (k1 * c.x + k0 * c.y) * 0.125f;
            vs[tt * 64 + 2 * i] = bf2f(vv & 0xffff); vs[tt * 64 + 2 * i + 1] = bf2f(vv >> 16);
        }
        __syncthreads();
        for (int tt = 0; tt < 32; ++tt) {
            const f32x4 ka = *(const LAS f32x4*)(ks + tt * 64 + wave * 8), kb = *(const LAS f32x4*)(ks + tt * 64 + wave * 8 + 4);
            const f32x4 qa = *(const LAS f32x4*)(qs + tt * 64 + wave * 8), qb = *(const LAS f32x4*)(qs + tt * 64 + wave * 8 + 4);
            const float v = vs[tt * 64 + lane];
            float po = 0.f;
#pragma unroll
            for (int i = 0; i < 4; ++i) { S[i] = gamma * S[i] + ka[i] * v; po += qa[i] * S[i]; S[4 + i] = gamma * S[4 + i] + kb[i] * v; po += qb[i] * S[4 + i]; }
            op[(tt * 8 + wave) * 64 + lane] = po;
        }
        __syncthreads();
#pragma unroll
        for (int r = 0; r < 4; ++r) {
            const int tt = wave + 8 * r, pos = tb * 32 + tt;
            float o = 0.f;
#pragma unroll
            for (int w = 0; w < 8; ++w) o += op[(tt * 8 + w) * 64 + lane];
            const float rstd = rsqrtf(wave_sum(o * o) * (1.f / 64.f) + EPS);
            const size_t row = (size_t)(b * SEQ + pos);
            const float g = bf2f(Z[row * ZW + ZC_RG + h * 64 + lane]);
            const float sg = g / (1.f + __expf(-g));
            MIX[row * DM + h * 64 + lane] = (bf16_t)f2bf(sg * o * rstd);
        }
        __syncthreads();
    }
}

__device__ __forceinline__ void conv_item(const KArgs& a, int l, int item) {
    const bf16_t* Z = (const bf16_t*)(a.ws + WS_Z);
    bf16_t* MIX = (bf16_t*)(a.ws + WS_MIX);
    const float* cw = a.in[I_CONV_W] + (size_t)l * 3 * 256;
    int tid = threadIdx.x; asm volatile("" : "+v"(tid));
    const int cg8 = (tid & 31) * 8;
    float w0[8], w1[8], w2[8];
#pragma unroll
    for (int i = 0; i < 8; ++i) { w0[i] = cw[cg8 + i]; w1[i] = cw[256 + cg8 + i]; w2[i] = cw[512 + cg8 + i]; }
    const int rbase = item * 256 + (tid >> 5) * 16;
    for (int q = 0; q < 4; ++q) {
        const int r0 = rbase + 4 * q, s0 = r0 & (SEQ - 1);
        u32x4 cc[6], hh[6], bb[4];
#pragma unroll
        for (int i = 0; i < 6; ++i) { const int rr = (s0 == 0 && i < 2) ? r0 : r0 - 2 + i; const bf16_t* zr = Z + (size_t)rr * ZW + cg8; cc[i] = *(const u32x4*)(zr + ZC_CC); hh[i] = *(const u32x4*)(zr + ZC_CH); }
#pragma unroll
        for (int i = 0; i < 4; ++i) bb[i] = *(const u32x4*)(Z + (size_t)(r0 + i) * ZW + ZC_CB + cg8);
        float u[6][8];
#pragma unroll
        for (int i = 0; i < 6; ++i) { const float z = (s0 == 0 && i < 2) ? 0.f : 1.f;
#pragma unroll
            for (int j = 0; j < 4; ++j) { u[i][2 * j] = z * bf2f(cc[i][j] & 0xffff) * bf2f(hh[i][j] & 0xffff); u[i][2 * j + 1] = z * bf2f(cc[i][j] >> 16) * bf2f(hh[i][j] >> 16); } }
#pragma unroll
        for (int i = 0; i < 4; ++i) { u32x4 o;
#pragma unroll
            for (int j = 0; j < 4; ++j) {
                const float y0 = w0[2 * j] * u[i][2 * j] + w1[2 * j] * u[i + 1][2 * j] + w2[2 * j] * u[i + 2][2 * j];
                const float y1 = w0[2 * j + 1] * u[i][2 * j + 1] + w1[2 * j + 1] * u[i + 1][2 * j + 1] + w2[2 * j + 1] * u[i + 2][2 * j + 1];
                o[j] = pk2(bf2f(bb[i][j] & 0xffff) * y0, bf2f(bb[i][j] >> 16) * y1); }
            *(u32x4*)(MIX + (size_t)(r0 + i) * DM + 256 + cg8) = o; }
    }
}

__device__ __forceinline__ void knorm_item(const KArgs& a, int l, int item, int wave, int lane) {
    const bf16_t* Z = (const bf16_t*)(a.ws + WS_Z);
    const float kg = a.in[I_KN][l * 64 + lane];
    for (int r0 = 0; r0 < 128; r0 += 16) {
        float v[16];
#pragma unroll
        for (int i = 0; i < 16; ++i) { const int task = item * 1024 + wave * 128 + r0 + i, row = task >> 2, which = (task >> 1) & 1, g = task & 1;
            v[i] = bf2f(Z[(size_t)row * ZW + (which ? ZC_KW : ZC_KS) + g * 64 + lane]); }
#pragma unroll
        for (int i = 0; i < 16; ++i) { const int task = item * 1024 + wave * 128 + r0 + i, row = task >> 2, which = (task >> 1) & 1, g = task & 1;
            const float rstd = rsqrtf(wave_sum(v[i] * v[i]) * (1.f / 64.f) + EPS);
            bf16_t* dst = (bf16_t*)(a.ws + (which ? WS_KWN : WS_KSN));
            dst[(size_t)row * 128 + g * 64 + lane] = (bf16_t)f2bf(v[i] * rstd * kg); }
    }
}

__device__ __forceinline__ void cmp_item(const KArgs& a, int l, int item, LAS unsigned char* lds, int wave, int lane) {
    int tid = threadIdx.x; asm volatile("" : "+v"(tid));
    const int nc = item & 7, kv = (item >> 3) & 1, g = (item >> 4) & 1, b = item >> 5;
    const bf16_t* Z = (const bf16_t*)(a.ws + WS_Z);
    const float* pe = a.in[kv ? I_PEV : I_PEK] + (size_t)l * 2048;
    const float* w1 = a.in[kv ? I_W1V : I_W1K] + (size_t)l * 2048 * 64;
    const float* w2 = a.in[kv ? I_W2V : I_W2K] + (size_t)l * 64 * 64;
    LAS float* xs = (LAS float*)lds;
    LAS float* red = xs + 272 * 64;
    LAS float* o1 = red + 8 * 16 * 64;
    const int t0 = nc * 256, zc = (kv ? ZC_VC : ZC_KC) + g * 64;
    for (int e = tid; e < 272 * 8; e += NTHREADS) {
        const int tt = e >> 3, c8 = (e & 7) * 8, tok = t0 + tt;
        u32x4 v = (u32x4){0u, 0u, 0u, 0u};
        if (tok < SEQ) v = *(const u32x4*)(Z + (size_t)(b * SEQ + tok) * ZW + zc + c8);
#pragma unroll
        for (int i = 0; i < 4; ++i) { xs[tt * 64 + c8 + 2 * i] = bf2f(v[i] & 0xffff); xs[tt * 64 + c8 + 2 * i + 1] = bf2f(v[i] >> 16); }
    }
    __syncthreads();
    float acc[16]; float accb = 0.f;
#pragma unroll
    for (int i = 0; i < 16; ++i) acc[i] = 0.f;
    for (int kk = 0; kk < 256; ++kk) {
        const int k = wave * 256 + kk, lpos = k >> 6, d = k & 63;
        const float w = w1[(size_t)k * 64 + lane];
        accb += pe[k] * w;
#pragma unroll
        for (int nb = 0; nb < 16; ++nb) acc[nb] += xs[(16 * nb + lpos) * 64 + d] * w;
    }
#pragma unroll
    for (int nb = 0; nb < 16; ++nb) red[(wave * 16 + nb) * 64 + lane] = acc[nb] + accb;
    __syncthreads();
    for (int e = tid; e < 16 * 64; e += NTHREADS) {
        float s = 0.f;
#pragma unroll
        for (int w = 0; w < 8; ++w) s += red[w * 16 * 64 + e];
        o1[e] = s / (1.f + __expf(-s));
    }
    __syncthreads();
    const float kg = a.in[I_KN][l * 64 + lane];
    bf16_t* dst = (bf16_t*)(a.ws + (kv ? WS_VCMP : WS_KCMP)) + (size_t)((b * 2 + g) * 128) * 64;
#pragma unroll
    for (int r = 0; r < 2; ++r) {
        const int nb = wave + 8 * r, n = nc * 16 + nb;
        float s = 0.f;
        for (int j = 0; j < 64; ++j) s += o1[nb * 64 + j] * w2[j * 64 + lane];
        if (!kv) { const float rstd = rsqrtf(wave_sum(s * s) * (1.f / 64.f) + EPS); s = s * rstd * kg; }
        if (n >= 127) s = 0.f;
        dst[(size_t)n * 64 + lane] = (bf16_t)f2bf(s);
    }
    __syncthreads();
}

__device__ __forceinline__ f32x4 dot4(const bf16_t* krow, const LAS float* qs) {
    float a0 = 0.f, a1 = 0.f, a2 = 0.f, a3 = 0.f;
#pragma unroll 1
    for (int c = 0; c < 8; ++c) {
        const u32x4 kv = *(const u32x4*)(krow + c * 8);
        float k[8];
#pragma unroll
        for (int i = 0; i < 4; ++i) { k[2 * i] = bf2f(kv[i] & 0xffff); k[2 * i + 1] = bf2f(kv[i] >> 16); }
#pragma unroll
        for (int h = 0; h < 4; ++h) {
            const f32x4 q0 = *(const LAS f32x4*)(qs + h * 64 + c * 8), q1 = *(const LAS f32x4*)(qs + h * 64 + c * 8 + 4);
            const float s = k[0] * q0[0] + k[1] * q0[1] + k[2] * q0[2] + k[3] * q0[3] + k[4] * q1[0] + k[5] * q1[1] + k[6] * q1[2] + k[7] * q1[3];
            if (h == 0) a0 += s; else if (h == 1) a1 += s; else if (h == 2) a2 += s; else a3 += s;
        }
    }
    return (f32x4){a0, a1, a2, a3};
}
__device__ __forceinline__ void blk_step(const f32x4 s, bool valid, const bf16_t* vbase, size_t vstride, int nk, LAS f32x4* pbuf, int lane, f32x4& m, f32x4& ls, f32x4& o) {
    f32x4 p;
#pragma unroll
    for (int h = 0; h < 4; ++h) {
        const float sm = valid ? s[h] : -1e30f;
        const float mn = fmaxf(m[h], wave_max(sm));
        const float sc = exp2f(m[h] - mn);
        p[h] = valid ? exp2f(s[h] - mn) : 0.f;
        ls[h] = ls[h] * sc + p[h]; o[h] *= sc; m[h] = mn;
    }
    LDS_FENCE();
    pbuf[lane] = p;
    LDS_FENCE();
    for (int key = 0; key < nk; ++key) {
        const f32x4 pp = pbuf[key];
        const float v = bf2f(vbase[(size_t)key * vstride + lane]);
        o[0] += pp[0] * v; o[1] += pp[1] * v; o[2] += pp[2] * v; o[3] += pp[3] * v;
    }
    LDS_FENCE();
}

__device__ __forceinline__ void nsa_task(const KArgs& a, int l, int b, int g, int t, LAS float* qs, LAS f32x4* pbuf, int lane_in) {
    int lane = lane_in; asm volatile("" : "+v"(lane));
    const bf16_t* Z = (const bf16_t*)(a.ws + WS_Z);
    const size_t row = (size_t)b * SEQ + t;
    const bf16_t* zrow = Z + row * ZW;
    {
        const int h = lane >> 4, dq = (lane & 15) * 4;
        const u32x2 qq = *(const u32x2*)(zrow + ZC_NQ + g * 256 + h * 64 + dq);
        float q0 = bf2f(qq.x & 0xffff), q1 = bf2f(qq.x >> 16), q2 = bf2f(qq.y & 0xffff), q3 = bf2f(qq.y >> 16);
        float ss = q0 * q0 + q1 * q1 + q2 * q2 + q3 * q3;
        ss += __shfl_xor(ss, 1); ss += __shfl_xor(ss, 2); ss += __shfl_xor(ss, 4); ss += __shfl_xor(ss, 8);
        const float rs = rsqrtf(ss * (1.f / 64.f) + EPS) * (0.125f * LOG2E);
        const f32x4 gq = *(const f32x4*)(a.in[I_QN] + l * 64 + dq);
        LDS_FENCE();
        *(LAS f32x4*)(qs + h * 64 + dq) = (f32x4){q0 * rs * gq[0], q1 * rs * gq[1], q2 * rs * gq[2], q3 * rs * gq[3]};
        LDS_FENCE();
    }
    const int nvis = (t >= 31) ? (((t - 31) >> 4) + 1) : 0;
    const bf16_t* kc = (const bf16_t*)(a.ws + WS_KCMP) + (size_t)((b * 2 + g) * 128) * 64;
    const bf16_t* vc = (const bf16_t*)(a.ws + WS_VCMP) + (size_t)((b * 2 + g) * 128) * 64;
    f32x4 ocmp = (f32x4){0.f, 0.f, 0.f, 0.f};
    float imp = 0.f;
    {
        const bool v1 = lane < nvis, v2 = lane + 64 < nvis;
        const f32x4 s1 = dot4(kc + (size_t)lane * 64, qs), s2 = dot4(kc + (size_t)(lane + 64) * 64, qs);
        f32x4 p1, p2;
#pragma unroll
        for (int h = 0; h < 4; ++h) {
            const float m = wave_max(fmaxf(v1 ? s1[h] : -1e30f, v2 ? s2[h] : -1e30f));
            p1[h] = v1 ? exp2f(s1[h] - m) : 0.f; p2[h] = v2 ? exp2f(s2[h] - m) : 0.f;
            const float inv = 1.f / fmaxf(wave_sum(p1[h] + p2[h]), 1e-30f);
            p1[h] *= inv; p2[h] *= inv;
        }
        LDS_FENCE();
        pbuf[lane] = p1; pbuf[lane + 64] = p2;
        LDS_FENCE();
        {
            const int j = lane & 31;
            const f32x4 pa = pbuf[4 * j], pb = pbuf[4 * j + 1], pc = pbuf[4 * j + 2], pd = pbuf[4 * j + 3];
            f32x4 pe = (f32x4){0.f, 0.f, 0.f, 0.f}; if (j > 0) pe = pbuf[4 * j - 1];
#pragma unroll
            for (int h = 0; h < 4; ++h) imp += pa[h] + pb[h] + pc[h] + 0.5f * pd[h] + 0.5f * pe[h];
        }
        for (int n = 0; n < nvis; ++n) {
            const f32x4 pp = pbuf[n];
            const float v = bf2f(vc[(size_t)n * 64 + lane]);
            ocmp[0] += pp[0] * v; ocmp[1] += pp[1] * v; ocmp[2] += pp[2] * v; ocmp[3] += pp[3] * v;
        }
        LDS_FENCE();
    }
    const int tb = t >> 6;
    unsigned mask;
    {
        const int j = lane & 31;
        const bool elig = j <= tb, forced = (j == 0) || (j == tb) || (j == tb - 1);
        const float sc = elig ? (imp + (forced ? 1e4f : 0.f)) : -1.0f;
        int rank = 0;
#pragma unroll
        for (int jj = 0; jj < 32; ++jj) { const float o = __uint_as_float(__builtin_amdgcn_readlane(__float_as_uint(sc), jj)); rank += (o > sc || (o == sc && jj < j)) ? 1 : 0; }
        mask = (unsigned)(__ballot(rank < 8 && lane < 32) & 0xffffffffull);
    }
    f32x4 ms = (f32x4){-1e30f, -1e30f, -1e30f, -1e30f}, lsl = (f32x4){0.f, 0.f, 0.f, 0.f}, os = (f32x4){0.f, 0.f, 0.f, 0.f};
    const bf16_t* ksn = (const bf16_t*)(a.ws + WS_KSN) + (size_t)b * SEQ * 128 + g * 64;
    for (int j = 0; j <= tb; ++j) {
        if (!((mask >> j) & 1u)) continue;
        const int key = 64 * j + lane; const bool valid = key <= t;
        const f32x4 s = dot4(ksn + (size_t)key * 128, qs);
        const int nk = min(64, t - 64 * j + 1);
        blk_step(s, valid, Z + ((size_t)b * SEQ + 64 * j) * ZW + ZC_VS + g * 64, ZW, nk, pbuf, lane, ms, lsl, os);
    }
    f32x4 mw = (f32x4){-1e30f, -1e30f, -1e30f, -1e30f}, lw = (f32x4){0.f, 0.f, 0.f, 0.f}, ow = (f32x4){0.f, 0.f, 0.f, 0.f};
    const bf16_t* kwn = (const bf16_t*)(a.ws + WS_KWN) + (size_t)b * SEQ * 128 + g * 64;
    for (int j = max(0, tb - 4); j <= tb; ++j) {
        const int key = 64 * j + lane; const bool valid = (key <= t) && (key > t - 256);
        const f32x4 s = dot4(kwn + (size_t)key * 128, qs);
        const int nk = min(64, t - 64 * j + 1);
        blk_step(s, valid, Z + ((size_t)b * SEQ + 64 * j) * ZW + ZC_VW + g * 64, ZW, nk, pbuf, lane, mw, lw, ow);
    }
    bf16_t* MIX = (bf16_t*)(a.ws + WS_MIX);
#pragma unroll
    for (int h = 0; h < 4; ++h) {
        const float l1 = wave_sum(lsl[h]), l2 = wave_sum(lw[h]);
        const bf16_t* gp = zrow + ZC_NG + (g * 4 + h) * 3;
        const float g0 = 1.f / (1.f + __expf(-bf2f(gp[0]))), g1 = 1.f / (1.f + __expf(-bf2f(gp[1]))), g2 = 1.f / (1.f + __expf(-bf2f(gp[2])));
        const float o = g0 * ocmp[h] + g1 * os[h] / fmaxf(l1, 1e-30f) + g2 * ow[h] / fmaxf(l2, 1e-30f);
        MIX[row * DM + 512 + (g * 4 + h) * 64 + lane] = (bf16_t)f2bf(o);
    }
}

__device__ __forceinline__ void phase_nsa(const KArgs& a, int l, LAS unsigned char* lds, int wave, int lane) {
    LAS float* qs = (LAS float*)(lds + wave * 4096);
    LAS f32x4* pbuf = (LAS f32x4*)(lds + wave * 4096 + 1024);
    const int gw = blockIdx.x * NWAVES + wave, NGW = gridDim.x * NWAVES;
    for (int task = gw; task < NB * 2 * SEQ; task += NGW) {
        const int bg = task >> 11, t = task & (SEQ - 1);
        nsa_task(a, l, bg >> 1, bg & 1, t, qs, pbuf, lane);
    }
}

typedef float f32x16 __attribute__((ext_vector_type(16)));
typedef short s16x4 __attribute__((ext_vector_type(4)));
constexpr int KST = 144, VST = 192;
constexpr int L_KC = 0, L_VC = 18432, L_KT = 43008, L_VT = 61440, L_IMP = 86016, L_SEL = 102400, L_UNI = 102656;
__device__ __forceinline__ int crow(int r, int hi) { return (r & 3) + 8 * (r >> 2) + 4 * hi; }
__device__ __forceinline__ s16x4 tr_read(const LAS unsigned char* p) { return __builtin_bit_cast(s16x4, __builtin_amdgcn_ds_read_tr16_b64_v4i16((LAS s16x4*)p)); }
__device__ __forceinline__ bf16x8 pack8(const f32x16& P, int base) {
    u32x4 w; w.x = pg8::cvt_pk_bf16(P[base + 0], P[base + 1]); w.y = pg8::cvt_pk_bf16(P[base + 2], P[base + 3]); w.z = pg8::cvt_pk_bf16(P[base + 4], P[base + 5]); w.w = pg8::cvt_pk_bf16(P[base + 6], P[base + 7]);
    return __builtin_bit_cast(bf16x8, w);
}
__device__ __forceinline__ void pv_step(f32x16 (&o)[2], const LAS unsigned char* vt, int s, bf16x8 bfrag, int lane) {
    const int i = lane & 15, hi = lane >> 5, dh = (lane >> 4) & 1;
    const LAS unsigned char* p = vt + (16 * s + 4 * hi + (i >> 2)) * VST + (16 * dh + 4 * (i & 3)) * 2;
#pragma unroll
    for (int dt = 0; dt < 2; ++dt) {
        const s16x4 lo = tr_read(p + dt * 64), hh = tr_read(p + dt * 64 + 8 * VST);
        const bf16x8 af = (bf16x8){lo[0], lo[1], lo[2], lo[3], hh[0], hh[1], hh[2], hh[3]};
        o[dt] = __builtin_amdgcn_mfma_f32_32x32x16_bf16(af, bfrag, o[dt], 0, 0, 0);
    }
}
__device__ __forceinline__ void nsa_mfma_item(const KArgs& a, int l, int b, int g, int tq, LAS unsigned char* lds, int wave, int lane_in, float shiftc) {
    int lane = lane_in; asm volatile("" : "+v"(lane));
    const int tid = wave * 64 + lane;
    const bf16_t* Z = (const bf16_t*)(a.ws + WS_Z);
    const int t0 = tq * 64, tb = tq; const size_t rowbase = (size_t)b * SEQ;
    const int c = lane & 31, hi = lane >> 5, tl = c >> 2, h = c & 3;
    const int tok = 8 * wave + tl, t = t0 + tok;
    __syncthreads();
    {
        const bf16_t* kc = (const bf16_t*)(a.ws + WS_KCMP) + (size_t)((b * 2 + g) * 128) * 64;
        const bf16_t* vc = (const bf16_t*)(a.ws + WS_VCMP) + (size_t)((b * 2 + g) * 128) * 64;
#pragma unroll
        for (int r = 0; r < 2; ++r) { const int e = tid + r * NTHREADS, key = e >> 3, ch = e & 7;
            const u32x4 kk = *(const u32x4*)(kc + key * 64 + ch * 8), vv = *(const u32x4*)(vc + key * 64 + ch * 8);
            *(LAS u32x4*)(lds + L_KC + key * KST + ch * 16) = kk; *(LAS u32x4*)(lds + L_VC + key * VST + ch * 16) = vv; }
    }
    const int skey = tid >> 3, sch = tid & 7;
    u32x4 kregA, vregA, kregB = (u32x4){0u, 0u, 0u, 0u}, vregB = (u32x4){0u, 0u, 0u, 0u};
    const bf16_t* ksn = (const bf16_t*)(a.ws + WS_KSN); const bf16_t* kwn = (const bf16_t*)(a.ws + WS_KWN);
#define NSA_LOAD_TILE(idx, KR, VR) do { const int ty_ = (idx) >> 5, j_ = (idx) & 31; const size_t row_ = rowbase + 64 * j_ + skey; \
        KR = *(const u32x4*)((ty_ ? kwn : ksn) + row_ * 128 + g * 64 + sch * 8); \
        VR = *(const u32x4*)(Z + row_ * ZW + (ty_ ? ZC_VW : ZC_VS) + g * 64 + sch * 8); } while (0)
    NSA_LOAD_TILE(0, kregA, vregA);
    const bf16_t* zrow = Z + (rowbase + t) * ZW;
    bf16x8 qf[4];
    {
        u32x4 raw[4]; float ss = 0.f;
#pragma unroll
        for (int ks = 0; ks < 4; ++ks) { raw[ks] = *(const u32x4*)(zrow + ZC_NQ + g * 256 + h * 64 + 16 * ks + 8 * hi);
#pragma unroll
            for (int i = 0; i < 4; ++i) { const float x0 = bf2f(raw[ks][i] & 0xffff), x1 = bf2f(raw[ks][i] >> 16); ss += x0 * x0 + x1 * x1; } }
        ss += __shfl_xor(ss, 32);
        const float rs = rsqrtf(ss * (1.f / 64.f) + EPS) * (0.125f * LOG2E);
#pragma unroll
        for (int ks = 0; ks < 4; ++ks) { const float* gp = a.in[I_QN] + l * 64 + 16 * ks + 8 * hi; const f32x4 ga = *(const f32x4*)gp, gb = *(const f32x4*)(gp + 4);
            u32x4 w;
            w.x = pg8::cvt_pk_bf16(bf2f(raw[ks][0] & 0xffff) * rs * ga[0], bf2f(raw[ks][0] >> 16) * rs * ga[1]);
            w.y = pg8::cvt_pk_bf16(bf2f(raw[ks][1] & 0xffff) * rs * ga[2], bf2f(raw[ks][1] >> 16) * rs * ga[3]);
            w.z = pg8::cvt_pk_bf16(bf2f(raw[ks][2] & 0xffff) * rs * gb[0], bf2f(raw[ks][2] >> 16) * rs * gb[1]);
            w.w = pg8::cvt_pk_bf16(bf2f(raw[ks][3] & 0xffff) * rs * gb[2], bf2f(raw[ks][3] >> 16) * rs * gb[3]);
            qf[ks] = __builtin_bit_cast(bf16x8, w); }
    }
    float g0, g1, g2;
    { const bf16_t* gp = zrow + ZC_NG + (g * 4 + h) * 3; g0 = 1.f / (1.f + __expf(-bf2f(gp[0]))); g1 = 1.f / (1.f + __expf(-bf2f(gp[1]))); g2 = 1.f / (1.f + __expf(-bf2f(gp[2]))); }
    __syncthreads();
    f32x16 otot[2];
    unsigned mymask;
    {
        f32x16 pc[4];
#pragma unroll
        for (int kt = 0; kt < 4; ++kt) { pc[kt] = (f32x16){};
#pragma unroll
            for (int ks = 0; ks < 4; ++ks) { const bf16x8 kf = *(const LAS bf16x8*)(lds + L_KC + (32 * kt + c) * KST + (16 * ks + 8 * hi) * 2);
                pc[kt] = __builtin_amdgcn_mfma_f32_32x32x16_bf16(kf, qf[ks], pc[kt], 0, 0, 0); } }
        const int nvis = (t >= 31) ? (((t - 31) >> 4) + 1) : 0;
        float mx = -1e30f;
#pragma unroll
        for (int kt = 0; kt < 4; ++kt)
#pragma unroll
            for (int r = 0; r < 16; ++r) { const int n = 32 * kt + crow(r, hi); const float sv = (n < nvis) ? pc[kt][r] : -INFINITY; pc[kt][r] = sv; mx = fmaxf(mx, sv); }
        mx = fmaxf(mx, __shfl_xor(mx, 32));
        float sum = 0.f;
#pragma unroll
        for (int kt = 0; kt < 4; ++kt)
#pragma unroll
            for (int r = 0; r < 16; ++r) { const float p = __builtin_amdgcn_exp2f(pc[kt][r] - mx); pc[kt][r] = p; sum += p; }
        sum += __shfl_xor(sum, 32);
        const float inv = 1.f / fmaxf(sum, 1e-30f);
#pragma unroll
        for (int kt = 0; kt < 4; ++kt)
#pragma unroll
            for (int r = 0; r < 16; ++r) pc[kt][r] *= inv;
        LAS float* impA = (LAS float*)(lds + L_IMP + wave * 2048); LAS float* impC = impA + 256;
#pragma unroll
        for (int kt = 0; kt < 4; ++kt)
#pragma unroll
            for (int gq = 0; gq < 4; ++gq) {
                float A = pc[kt][4 * gq] + pc[kt][4 * gq + 1] + pc[kt][4 * gq + 2] + 0.5f * pc[kt][4 * gq + 3], C = 0.5f * pc[kt][4 * gq + 3];
                A += __shfl_xor(A, 1); A += __shfl_xor(A, 2); C += __shfl_xor(C, 1); C += __shfl_xor(C, 2);
                const int j = 8 * kt + 2 * gq + hi;
                if (h == 0) { impA[tl * 32 + j] = A; if (j < 31) impC[tl * 32 + j + 1] = C; }
            }
        if (h == 0 && hi == 0) impC[tl * 32] = 0.f;
        f32x16 oc[2]; oc[0] = (f32x16){}; oc[1] = (f32x16){};
#pragma unroll
        for (int s8 = 0; s8 < 8; ++s8) pv_step(oc, lds + L_VC, s8, pack8(pc[s8 >> 1], 8 * (s8 & 1)), lane);
#pragma unroll
        for (int dt = 0; dt < 2; ++dt)
#pragma unroll
            for (int r = 0; r < 16; ++r) otot[dt][r] = g0 * oc[dt][r];
        LDS_FENCE();
        const int tk = lane >> 3, jg = lane & 7;
        const LAS float* ia = impA + tk * 32; const LAS float* ic = impC + tk * 32;
        float sc[32];
#pragma unroll
        for (int q4 = 0; q4 < 8; ++q4) { const f32x4 x = *(const LAS f32x4*)(ia + 4 * q4) + *(const LAS f32x4*)(ic + 4 * q4);
#pragma unroll
            for (int u = 0; u < 4; ++u) { const int j = 4 * q4 + u; const bool forced = (j == 0) || (j == tb) || (j == tb - 1); sc[j] = (j <= tb) ? (x[u] + (forced ? 1e4f : 0.f)) : -1.0f; } }
        float so[4];
        { const f32x4 x = *(const LAS f32x4*)(ia + 4 * jg) + *(const LAS f32x4*)(ic + 4 * jg);
#pragma unroll
            for (int u = 0; u < 4; ++u) { const int j = 4 * jg + u; const bool forced = (j == 0) || (j == tb) || (j == tb - 1); so[u] = (j <= tb) ? (x[u] + (forced ? 1e4f : 0.f)) : -1.0f; } }
        unsigned part = 0u;
#pragma unroll
        for (int u = 0; u < 4; ++u) { const int j = 4 * jg + u; int rank = 0;
#pragma unroll
            for (int jj = 0; jj < 32; ++jj) rank += (sc[jj] > so[u] || (sc[jj] == so[u] && jj < j)) ? 1 : 0;
            part |= (rank < 8 ? 1u : 0u) << j; }
        part |= __shfl_xor(part, 1); part |= __shfl_xor(part, 2); part |= __shfl_xor(part, 4);
        LAS unsigned* selm = (LAS unsigned*)(lds + L_SEL);
        if (jg == 0) selm[wave * 8 + tk] = part;
        unsigned uni = part; uni |= __shfl_xor(uni, 8); uni |= __shfl_xor(uni, 16); uni |= __shfl_xor(uni, 32);
        if (lane == 0) ((LAS unsigned*)(lds + L_UNI))[wave] = uni;
        LDS_FENCE();
        mymask = selm[wave * 8 + tl];
    }
    __syncthreads();
    unsigned uniall = 0u;
    { const LAS unsigned* up = (const LAS unsigned*)(lds + L_UNI);
#pragma unroll
        for (int w = 0; w < 8; ++w) uniall |= up[w]; }
    uniall = __builtin_amdgcn_readfirstlane(uniall);
    const unsigned upto = (2u << tb) - 1u;
    const int wlo = tb - 4 > 0 ? tb - 4 : 0;
    unsigned long long list = (unsigned long long)(uniall & upto) | ((unsigned long long)(upto & ~((1u << wlo) - 1u)) << 32);
    float lsum = 0.f; f32x16 o[2]; o[0] = (f32x16){}; o[1] = (f32x16){};
    int curA = 0, curB = -1; list &= list - 1ull;
    int buf = 0, prevtype = 0;
    while (curA >= 0) {
        LAS unsigned char* sb = lds + buf * 43008;
        *(LAS u32x4*)(sb + skey * KST + sch * 16) = kregA; *(LAS u32x4*)(sb + 18432 + skey * VST + sch * 16) = vregA;
        if (curB >= 0) { *(LAS u32x4*)(sb + (64 + skey) * KST + sch * 16) = kregB; *(LAS u32x4*)(sb + 18432 + (64 + skey) * VST + sch * 16) = vregB; }
        __syncthreads();
        int nxtA = -1, nxtB = -1;
        if (list) { nxtA = __builtin_ctzll(list); list &= list - 1ull; NSA_LOAD_TILE(nxtA, kregA, vregA);
            if (list) { const int nb_ = __builtin_ctzll(list); if ((nb_ >> 5) == (nxtA >> 5)) { nxtB = nb_; list &= list - 1ull; NSA_LOAD_TILE(nxtB, kregB, vregB); } } }
        const int type = curA >> 5, jA = curA & 31, jB = curB & 31; const bool hasB = curB >= 0;
        if (type != prevtype) {
            const float lt = lsum + __shfl_xor(lsum, 32); const float f = g1 / fmaxf(lt, 1e-30f);
#pragma unroll
            for (int dt = 0; dt < 2; ++dt)
#pragma unroll
                for (int r = 0; r < 16; ++r) { otot[dt][r] += f * o[dt][r]; o[dt][r] = 0.f; }
            lsum = 0.f; prevtype = type;
        }
        int kloA, khiA, kloB = 0, khiB = -1;
        if (type == 0) { kloA = 0; khiA = ((mymask >> jA) & 1u) ? (jA == tb ? tok : 63) : -1; if (hasB) khiB = ((mymask >> jB) & 1u) ? (jB == tb ? tok : 63) : -1; }
        else { kloA = (jA == tb - 4) ? tok + 1 : 0; khiA = (jA == tb) ? tok : 63; if (hasB) { kloB = (jB == tb - 4) ? tok + 1 : 0; khiB = (jB == tb) ? tok : 63; } }
        const bool colA = khiA >= kloA, colB = khiB >= kloB;
        if (__any(colA || colB)) {
            const LAS unsigned char* kt_ = sb; const LAS unsigned char* vt_ = sb + 18432;
            f32x16 p0 = (f32x16){}, p1 = (f32x16){}, p2 = (f32x16){}, p3 = (f32x16){};
            __builtin_amdgcn_s_setprio(1);
#pragma unroll
            for (int ks = 0; ks < 4; ++ks) {
                const bf16x8 k0 = *(const LAS bf16x8*)(kt_ + c * KST + (16 * ks + 8 * hi) * 2), k1 = *(const LAS bf16x8*)(kt_ + (c + 32) * KST + (16 * ks + 8 * hi) * 2);
                p0 = __builtin_amdgcn_mfma_f32_32x32x16_bf16(k0, qf[ks], p0, 0, 0, 0); p1 = __builtin_amdgcn_mfma_f32_32x32x16_bf16(k1, qf[ks], p1, 0, 0, 0);
            }
            if (hasB) {
#pragma unroll
                for (int ks = 0; ks < 4; ++ks) {
                    const bf16x8 k2 = *(const LAS bf16x8*)(kt_ + (c + 64) * KST + (16 * ks + 8 * hi) * 2), k3 = *(const LAS bf16x8*)(kt_ + (c + 96) * KST + (16 * ks + 8 * hi) * 2);
                    p2 = __builtin_amdgcn_mfma_f32_32x32x16_bf16(k2, qf[ks], p2, 0, 0, 0); p3 = __builtin_amdgcn_mfma_f32_32x32x16_bf16(k3, qf[ks], p3, 0, 0, 0);
                }
            }
            __builtin_amdgcn_s_setprio(0);
            if ((jA == tb) || (type == 1 && jA == tb - 4)) {
#pragma unroll
                for (int r = 0; r < 16; ++r) { const int k0 = crow(r, hi), k1 = k0 + 32;
                    p0[r] = (k0 >= kloA && k0 <= khiA) ? p0[r] : -INFINITY; p1[r] = (k1 >= kloA && k1 <= khiA) ? p1[r] : -INFINITY; }
            }
            if (hasB && ((jB == tb) || (type == 1 && jB == tb - 4))) {
#pragma unroll
                for (int r = 0; r < 16; ++r) { const int k0 = crow(r, hi), k1 = k0 + 32;
                    p2[r] = (k0 >= kloB && k0 <= khiB) ? p2[r] : -INFINITY; p3[r] = (k1 >= kloB && k1 <= khiB) ? p3[r] : -INFINITY; }
            }
            const float mrefA = colA ? shiftc : INFINITY;
            const pg8::f32x2_t mrA = {mrefA, mrefA}; pg8::f32x2_t ps0 = {0.f, 0.f}, ps1 = {0.f, 0.f};
#pragma unroll
            for (int r = 0; r < 16; r += 2) { pg8::f32x2_t v0 = {p0[r], p0[r + 1]}, v1 = {p1[r], p1[r + 1]}; v0 -= mrA; v1 -= mrA;
                v0.x = __builtin_amdgcn_exp2f(v0.x); v0.y = __builtin_amdgcn_exp2f(v0.y); v1.x = __builtin_amdgcn_exp2f(v1.x); v1.y = __builtin_amdgcn_exp2f(v1.y);
                ps0 += v0; ps1 += v1; p0[r] = v0.x; p0[r + 1] = v0.y; p1[r] = v1.x; p1[r + 1] = v1.y; }
            { const pg8::f32x2_t pt = ps0 + ps1; lsum += pt.x + pt.y; }
#pragma unroll
            for (int s = 0; s < 4; ++s) pv_step(o, vt_, s, (s < 2) ? pack8(p0, 8 * (s & 1)) : pack8(p1, 8 * (s & 1)), lane);
            if (hasB) {
                const float mrefB = colB ? shiftc : INFINITY;
                const pg8::f32x2_t mrB = {mrefB, mrefB}; pg8::f32x2_t ps2 = {0.f, 0.f}, ps3 = {0.f, 0.f};
#pragma unroll
                for (int r = 0; r < 16; r += 2) { pg8::f32x2_t v0 = {p2[r], p2[r + 1]}, v1 = {p3[r], p3[r + 1]}; v0 -= mrB; v1 -= mrB;
                    v0.x = __builtin_amdgcn_exp2f(v0.x); v0.y = __builtin_amdgcn_exp2f(v0.y); v1.x = __builtin_amdgcn_exp2f(v1.x); v1.y = __builtin_amdgcn_exp2f(v1.y);
                    ps2 += v0; ps3 += v1; p2[r] = v0.x; p2[r + 1] = v0.y; p3[r] = v1.x; p3[r + 1] = v1.y; }
                { const pg8::f32x2_t pt = ps2 + ps3; lsum += pt.x + pt.y; }
#pragma unroll
                for (int s = 0; s < 4; ++s) pv_step(o, vt_, 4 + s, (s < 2) ? pack8(p2, 8 * (s & 1)) : pack8(p3, 8 * (s & 1)), lane);
            }
        }
        buf ^= 1; curA = nxtA; curB = nxtB;
    }
    {
        const float lt = lsum + __shfl_xor(lsum, 32); const float f = g2 / fmaxf(lt, 1e-30f);
#pragma unroll
        for (int dt = 0; dt < 2; ++dt)
#pragma unroll
            for (int r = 0; r < 16; ++r) otot[dt][r] += f * o[dt][r];
    }
    bf16_t* orow = (bf16_t*)(a.ws + WS_MIX) + (rowbase + t) * DM + 512 + (g * 4 + h) * 64 + 4 * hi;
#pragma unroll
    for (int dt = 0; dt < 2; ++dt)
#pragma unroll
        for (int gq = 0; gq < 4; ++gq) { u32x2 w; w.x = pg8::cvt_pk_bf16(otot[dt][4 * gq], otot[dt][4 * gq + 1]); w.y = pg8::cvt_pk_bf16(otot[dt][4 * gq + 2], otot[dt][4 * gq + 3]);
            *(u32x2*)(orow + 32 * dt + 8 * gq) = w; }
#undef NSA_LOAD_TILE
}
__device__ __forceinline__ void phase_nsa_mfma(const KArgs& a, int l, LAS unsigned char* lds, int wave, int lane) {
    const float gq = wave_max(fabsf(a.in[I_QN][l * 64 + lane])), gk = wave_max(fabsf(a.in[I_KN][l * 64 + lane]));
    const float shiftc = __uint_as_float(__builtin_amdgcn_readfirstlane(__float_as_uint(fmaxf(0.f, 64.f * 0.125f * LOG2E * gq * gk - 60.f))));
    for (int it = blockIdx.x; it < NB * 2 * 32; it += gridDim.x) {
        const int k = it >> 8, pos = it & 255, grp = pos >> 6, bg = pos & 63;
        const int tq = 31 - (4 * k + ((k & 1) ? 3 - grp : grp));
        nsa_mfma_item(a, l, bg >> 1, bg & 1, tq, lds, wave, lane, shiftc);
    }
}

constexpr int N2_IMP = 43008, N2_SEL = 59392, N2_UNI = 59904, N2_OTP = 60416;
__device__ __forceinline__ void nsa2_softmax(f32x16& P, int kbase, bool col, bool bnd, int klo, int khi, int hi, float shiftc, float& lsum) {
    if (bnd) {
#pragma unroll
        for (int r = 0; r < 16; ++r) { const int k0 = kbase + crow(r, hi); P[r] = (k0 >= klo && k0 <= khi) ? P[r] : -INFINITY; }
    }
    const float mref = col ? shiftc : INFINITY; const pg8::f32x2_t mr = {mref, mref}; pg8::f32x2_t ps = {0.f, 0.f};
#pragma unroll
    for (int r = 0; r < 16; r += 2) { pg8::f32x2_t v = {P[r], P[r + 1]}; v -= mr; v.x = __builtin_amdgcn_exp2f(v.x); v.y = __builtin_amdgcn_exp2f(v.y); ps += v; P[r] = v.x; P[r + 1] = v.y; }
    lsum += ps.x + ps.y;
}
__device__ __forceinline__ void nsa2_item(const KArgs& a, int l, int b, int g, int T, LAS unsigned char* lds, int wave, int lane_in, float shiftc) {
    (void)lane_in; int lane = (int)__builtin_amdgcn_mbcnt_hi(~0u, __builtin_amdgcn_mbcnt_lo(~0u, 0u)); asm volatile("" : "+v"(lane));
    const int tid = wave * 64 + lane;
    const bf16_t* Z = (const bf16_t*)(a.ws + WS_Z);
    const int t0 = T * 128; const size_t rowbase = (size_t)b * SEQ;
    const int c = lane & 31, hi = lane >> 5, tl = c >> 2, h = c & 3;
    const int tok = 8 * wave + tl;
    __syncthreads();
    {
        const bf16_t* kc = (const bf16_t*)(a.ws + WS_KCMP) + (size_t)((b * 2 + g) * 128) * 64;
        const bf16_t* vc = (const bf16_t*)(a.ws + WS_VCMP) + (size_t)((b * 2 + g) * 128) * 64;
#pragma unroll
        for (int r = 0; r < 2; ++r) { const int e = tid + r * NTHREADS, key = e >> 3, ch = e & 7;
            const u32x4 kk = *(const u32x4*)(kc + key * 64 + ch * 8), vv = *(const u32x4*)(vc + key * 64 + ch * 8);
            *(LAS u32x4*)(lds + L_KC + key * KST + ch * 16) = kk; *(LAS u32x4*)(lds + L_VC + key * VST + ch * 16) = vv; }
    }
    const int skey = tid >> 3, sch = tid & 7;
    u32x4 kreg, vreg;
    const bf16_t* ksn = (const bf16_t*)(a.ws + WS_KSN); const bf16_t* kwn = (const bf16_t*)(a.ws + WS_KWN);
#define N2_LOAD_TILE(idx) do { const int ty_ = (idx) >> 5, j_ = (idx) & 31; const size_t row_ = rowbase + 64 * j_ + skey; \
        kreg = *(const u32x4*)((ty_ ? kwn : ksn) + row_ * 128 + g * 64 + sch * 8); \
        vreg = *(const u32x4*)(Z + row_ * ZW + (ty_ ? ZC_VW : ZC_VS) + g * 64 + sch * 8); } while (0)
    N2_LOAD_TILE(0);
    bf16x8 qf[2][4]; float g0[2]; unsigned g12[2];
    __syncthreads();
    LAS unsigned* otp = (LAS unsigned*)(lds + N2_OTP) + tid;
    unsigned uniw = 0u;
#pragma unroll
    for (int s = 0; s < 2; ++s) {
        {
        const bf16_t* zrow = Z + (rowbase + t0 + 64 * s + tok) * ZW;
        u32x4 raw[4]; float ss = 0.f;
#pragma unroll
        for (int ks = 0; ks < 4; ++ks) { raw[ks] = *(const u32x4*)(zrow + ZC_NQ + g * 256 + h * 64 + 16 * ks + 8 * hi);
#pragma unroll
            for (int i = 0; i < 4; ++i) { const float x0 = bf2f(raw[ks][i] & 0xffff), x1 = bf2f(raw[ks][i] >> 16); ss += x0 * x0 + x1 * x1; } }
        ss = x32_sum(ss);
        const float rs = rsqrtf(ss * (1.f / 64.f) + EPS) * (0.125f * LOG2E);
#pragma unroll
        for (int ks = 0; ks < 4; ++ks) { const float* gp = a.in[I_QN] + l * 64 + 16 * ks + 8 * hi; const f32x4 ga = *(const f32x4*)gp, gb = *(const f32x4*)(gp + 4);
            u32x4 w;
            w.x = pg8::cvt_pk_bf16(bf2f(raw[ks][0] & 0xffff) * rs * ga[0], bf2f(raw[ks][0] >> 16) * rs * ga[1]);
            w.y = pg8::cvt_pk_bf16(bf2f(raw[ks][1] & 0xffff) * rs * ga[2], bf2f(raw[ks][1] >> 16) * rs * ga[3]);
            w.z = pg8::cvt_pk_bf16(bf2f(raw[ks][2] & 0xffff) * rs * gb[0], bf2f(raw[ks][2] >> 16) * rs * gb[1]);
            w.w = pg8::cvt_pk_bf16(bf2f(raw[ks][3] & 0xffff) * rs * gb[2], bf2f(raw[ks][3] >> 16) * rs * gb[3]);
            if (s == 1 && ks == 3) *(LAS u32x4*)(lds + 125952 + tid * 16) = w; else qf[s][ks] = __builtin_bit_cast(bf16x8, w); }
        const bf16_t* gp = zrow + ZC_NG + (g * 4 + h) * 3;
        g0[s] = 1.f / (1.f + __expf(-bf2f(gp[0])));
        g12[s] = pg8::cvt_pk_bf16(1.f / (1.f + __expf(-bf2f(gp[1]))), 1.f / (1.f + __expf(-bf2f(gp[2]))));
        }
        const int t = t0 + 64 * s + tok, tb = 2 * T + s;
        f32x16 pc[4];
#pragma unroll
        for (int kt = 0; kt < 4; ++kt) { pc[kt] = (f32x16){};
#pragma unroll
            for (int ks = 0; ks < 4; ++ks) { const bf16x8 kf = *(const LAS bf16x8*)(lds + L_KC + (32 * kt + c) * KST + (16 * ks + 8 * hi) * 2);
                pc[kt] = __builtin_amdgcn_mfma_f32_32x32x16_bf16(kf, (s == 1 && ks == 3) ? *(const LAS bf16x8*)(lds + 125952 + tid * 16) : qf[s][ks], pc[kt], 0, 0, 0); } }
        const int nvis = (t >= 31) ? (((t - 31) >> 4) + 1) : 0;
        float mx = -1e30f;
#pragma unroll
        for (int kt = 0; kt < 4; ++kt)
#pragma unroll
            for (int r = 0; r < 16; ++r) { const int n = 32 * kt + crow(r, hi); const float sv = (n < nvis) ? pc[kt][r] : -INFINITY; pc[kt][r] = sv; mx = fmaxf(mx, sv); }
        mx = x32_max(mx);
        float sum = 0.f;
#pragma unroll
        for (int kt = 0; kt < 4; ++kt)
#pragma unroll
            for (int r = 0; r < 16; ++r) { const float p = __builtin_amdgcn_exp2f(pc[kt][r] - mx); pc[kt][r] = p; sum += p; }
        sum = x32_sum(sum);
        const float inv = 1.f / fmaxf(sum, 1e-30f);
#pragma unroll
        for (int kt = 0; kt < 4; ++kt)
#pragma unroll
            for (int r = 0; r < 16; ++r) pc[kt][r] *= inv;
        LAS float* impA = (LAS float*)(lds + N2_IMP + wave * 2048); LAS float* impC = impA + 256;
        LDS_FENCE();
#pragma unroll
        for (int kt = 0; kt < 4; ++kt)
#pragma unroll
            for (int gq = 0; gq < 4; ++gq) {
                float A = pc[kt][4 * gq] + pc[kt][4 * gq + 1] + pc[kt][4 * gq + 2] + 0.5f * pc[kt][4 * gq + 3], C = 0.5f * pc[kt][4 * gq + 3];
                A += swz_f<1>(A); A += swz_f<2>(A); C += swz_f<1>(C); C += swz_f<2>(C);
                const int j = 8 * kt + 2 * gq + hi;
                if (h == 0) { impA[tl * 32 + j] = A; if (j < 31) impC[tl * 32 + j + 1] = C; }
            }
        if (h == 0 && hi == 0) impC[tl * 32] = 0.f;
        f32x16 oc[2]; oc[0] = (f32x16){}; oc[1] = (f32x16){};
#pragma unroll
        for (int s8 = 0; s8 < 8; ++s8) pv_step(oc, lds + L_VC, s8, pack8(pc[s8 >> 1], 8 * (s8 & 1)), lane);
#pragma unroll
        for (int dt = 0; dt < 2; ++dt)
#pragma unroll
            for (int r = 0; r < 16; r += 2) otp[(16 * s + 8 * dt + (r >> 1)) * 512] = pg8::cvt_pk_bf16(g0[s] * oc[dt][r], g0[s] * oc[dt][r + 1]);
        LDS_FENCE();
        const int tk = lane >> 3, jg = lane & 7;
        const LAS float* ia = impA + tk * 32; const LAS float* ic = impC + tk * 32;
        float sc[32];
#pragma unroll
        for (int q4 = 0; q4 < 8; ++q4) { const f32x4 x = *(const LAS f32x4*)(ia + 4 * q4) + *(const LAS f32x4*)(ic + 4 * q4);
#pragma unroll
            for (int u = 0; u < 4; ++u) { const int j = 4 * q4 + u; const bool forced = (j == 0) || (j == tb) || (j == tb - 1); sc[j] = (j <= tb) ? (x[u] + (forced ? 1e4f : 0.f)) : -1.0f; } }
        float so[4];
        { const f32x4 x = *(const LAS f32x4*)(ia + 4 * jg) + *(const LAS f32x4*)(ic + 4 * jg);
#pragma unroll
            for (int u = 0; u < 4; ++u) { const int j = 4 * jg + u; const bool forced = (j == 0) || (j == tb) || (j == tb - 1); so[u] = (j <= tb) ? (x[u] + (forced ? 1e4f : 0.f)) : -1.0f; } }
        unsigned part = 0u;
#pragma unroll
        for (int u = 0; u < 4; ++u) { const int j = 4 * jg + u; int rank = 0;
#pragma unroll
            for (int jj = 0; jj < 32; ++jj) rank += (sc[jj] > so[u] || (sc[jj] == so[u] && jj < j)) ? 1 : 0;
            part |= (rank < 8 ? 1u : 0u) << j; }
        part |= swz_u<1>(part); part |= swz_u<2>(part); part |= swz_u<4>(part);
        LAS unsigned* selm = (LAS unsigned*)(lds + N2_SEL) + s * 64;
        if (jg == 0) selm[wave * 8 + tk] = part;
        unsigned uni = part; uni |= swz_u<8>(uni); uni |= swz_u<16>(uni); uni = x32_or(uni);
        uniw |= uni & ((2u << tb) - 1u);
        LDS_FENCE();
        __builtin_amdgcn_sched_barrier(0);
    }
    LDS_FENCE();
    *(LAS bf16x8*)(lds + N2_IMP + wave * 2048 + lane * 16) = qf[1][2];
    if (lane == 0) ((LAS unsigned*)(lds + N2_UNI))[wave] = uniw;
    __syncthreads();
    unsigned uniall = 0u;
    { const LAS unsigned* up = (const LAS unsigned*)(lds + N2_UNI);
#pragma unroll
        for (int w = 0; w < 8; ++w) uniall |= up[w]; }
    uniall = __builtin_amdgcn_readfirstlane(uniall);
    const int tb0 = 2 * T, tb1 = 2 * T + 1;
    const unsigned upto = (2u << tb1) - 1u;
    const int wlo = tb0 - 4 > 0 ? tb0 - 4 : 0;
    unsigned long long list = (unsigned long long)(uniall & upto) | ((unsigned long long)(upto & ~((1u << wlo) - 1u)) << 32);
    float lsum[2] = {0.f, 0.f}; f32x16 o[2][2];
#pragma unroll
    for (int s = 0; s < 2; ++s) { o[s][0] = (f32x16){}; o[s][1] = (f32x16){}; }
    int cur = 0; list &= list - 1ull;
    int buf = 0, prevtype = 0;
    while (cur >= 0) {
        LAS unsigned char* sb = lds + buf * 21504;
        *(LAS u32x4*)(sb + skey * KST + sch * 16) = kreg; *(LAS u32x4*)(sb + 9216 + skey * VST + sch * 16) = vreg;
        __syncthreads();
        int nxt = -1;
        if (list) { nxt = __builtin_ctzll(list); list &= list - 1ull; N2_LOAD_TILE(nxt); }
        const int type = cur >> 5, j = cur & 31;
        if (type != prevtype) {
#pragma unroll
            for (int s = 0; s < 2; ++s) {
                const float lt = x32_sum(lsum[s]); const float f = __uint_as_float(g12[s] << 16) / fmaxf(lt, 1e-30f);
#pragma unroll
                for (int dt = 0; dt < 2; ++dt)
#pragma unroll
                    for (int r = 0; r < 16; r += 2) { const unsigned w = otp[(16 * s + 8 * dt + (r >> 1)) * 512];
                        otp[(16 * s + 8 * dt + (r >> 1)) * 512] = pg8::cvt_pk_bf16(__uint_as_float(w << 16) + f * o[s][dt][r], __uint_as_float(w & 0xffff0000u) + f * o[s][dt][r + 1]); o[s][dt][r] = 0.f; o[s][dt][r + 1] = 0.f; }
                lsum[s] = 0.f; }
            prevtype = type;
        }
        int klo[2], khi[2]; bool col[2], bnd[2], act[2];
#pragma unroll
        for (int s = 0; s < 2; ++s) { const int tb = 2 * T + s;
            if (type == 0) { const unsigned mm_ = ((const LAS unsigned*)(lds + N2_SEL))[s * 64 + wave * 8 + tl]; klo[s] = 0; khi[s] = (j <= tb && ((mm_ >> j) & 1u)) ? (j == tb ? tok : 63) : -1; bnd[s] = (j == tb); }
            else { const bool in = (j <= tb) && (j >= tb - 4); klo[s] = (j == tb - 4) ? tok + 1 : 0; khi[s] = in ? ((j == tb) ? tok : 63) : -1; bnd[s] = (j == tb) || (j == tb - 4); }
            col[s] = khi[s] >= klo[s]; act[s] = __any(col[s]); }
        if (act[0] || act[1]) {
            const LAS unsigned char* kt_ = sb; const LAS unsigned char* vt_ = sb + 9216;
            const int i = lane & 15, dh = (lane >> 4) & 1;
#pragma unroll
            for (int sub = 0; sub < 2; ++sub) {
                f32x16 p[2]; p[0] = (f32x16){}; p[1] = (f32x16){};
#pragma unroll
                for (int ks = 0; ks < 4; ++ks) {
                    const bf16x8 kf = *(const LAS bf16x8*)(kt_ + (c + 32 * sub) * KST + (16 * ks + 8 * hi) * 2);
#pragma unroll
                    for (int s = 0; s < 2; ++s) if (act[s]) p[s] = __builtin_amdgcn_mfma_f32_32x32x16_bf16(kf, (s == 1 && ks == 3) ? *(const LAS bf16x8*)(lds + 125952 + tid * 16) : (s == 1 && ks == 2) ? *(const LAS bf16x8*)(lds + N2_IMP + wave * 2048 + lane * 16) : qf[s][ks], p[s], 0, 0, 0);
                }
#pragma unroll
                for (int s = 0; s < 2; ++s) if (act[s]) nsa2_softmax(p[s], 32 * sub, col[s], bnd[s], klo[s], khi[s], hi, shiftc, lsum[s]);
#pragma unroll
                for (int s4 = 2 * sub; s4 < 2 * sub + 2; ++s4) {
                    const LAS unsigned char* pvp = vt_ + (16 * s4 + 4 * hi + (i >> 2)) * VST + (16 * dh + 4 * (i & 3)) * 2;
                    bf16x8 bfr[2];
#pragma unroll
                    for (int s = 0; s < 2; ++s) bfr[s] = pack8(p[s], 8 * (s4 & 1));
#pragma unroll
                    for (int dt = 0; dt < 2; ++dt) {
                        const s16x4 lo = tr_read(pvp + dt * 64), hh = tr_read(pvp + dt * 64 + 8 * VST);
                        const bf16x8 af = (bf16x8){lo[0], lo[1], lo[2], lo[3], hh[0], hh[1], hh[2], hh[3]};
#pragma unroll
                        for (int s = 0; s < 2; ++s) if (act[s]) o[s][dt] = __builtin_amdgcn_mfma_f32_32x32x16_bf16(af, bfr[s], o[s][dt], 0, 0, 0);
                    }
                }
            }
        }
        buf ^= 1; cur = nxt;
    }
#pragma unroll
    for (int s = 0; s < 2; ++s) {
        const float lt = x32_sum(lsum[s]); const float f = __uint_as_float(g12[s] & 0xffff0000u) / fmaxf(lt, 1e-30f);
        bf16_t* orow = (bf16_t*)(a.ws + WS_MIX) + (rowbase + t0 + 64 * s + tok) * DM + 512 + (g * 4 + h) * 64 + 4 * hi;
#pragma unroll
        for (int dt = 0; dt < 2; ++dt)
#pragma unroll
            for (int gq = 0; gq < 4; ++gq) { u32x2 w;
                const unsigned w0 = otp[(16 * s + 8 * dt + 2 * gq) * 512], w1 = otp[(16 * s + 8 * dt + 2 * gq + 1) * 512];
                w.x = pg8::cvt_pk_bf16(__uint_as_float(w0 << 16) + f * o[s][dt][4 * gq], __uint_as_float(w0 & 0xffff0000u) + f * o[s][dt][4 * gq + 1]);
                w.y = pg8::cvt_pk_bf16(__uint_as_float(w1 << 16) + f * o[s][dt][4 * gq + 2], __uint_as_float(w1 & 0xffff0000u) + f * o[s][dt][4 * gq + 3]);
                *(u32x2*)(orow + 32 * dt + 8 * gq) = w; }
    }
#undef N2_LOAD_TILE
}
__device__ __forceinline__ void phase_nsa2(const KArgs& a, int l, LAS unsigned char* lds, int wave, int lane) {
    const float gq = wave_max(fabsf(a.in[I_QN][l * 64 + lane])), gk = wave_max(fabsf(a.in[I_KN][l * 64 + lane]));
    const float shiftc = __uint_as_float(__builtin_amdgcn_readfirstlane(__float_as_uint(fmaxf(0.f, 64.f * 0.125f * LOG2E * gq * gk - 60.f))));
    for (int it = blockIdx.x; it < NB * 2 * 16; it += gridDim.x) {
        const int k = it >> 8, pos = it & 255, grp = pos >> 6, bg = pos & 63;
        const int T = 15 - (4 * k + ((k & 1) ? 3 - grp : grp));
        nsa2_item(a, l, bg >> 1, bg & 1, T, lds, wave, lane, shiftc);
    }
}

constexpr int R_Q = 0, R_K = 18432, R_V = 36864, R_ST = 61440;
__device__ __forceinline__ void ret_mfma_item(const KArgs& a, int l, int bh, LAS unsigned char* lds, int wave, int lane_in) {
    int lane = lane_in; asm volatile("" : "+v"(lane));
    const int tid = wave * 64 + lane, b = bh >> 2, h = bh & 3;
    const float l2g = (h == 0) ? -0.04580368961312479f : (h == 1) ? -0.02272007650008353f : (h == 2) ? -0.011315313227834146f : -0.005646563141142062f;
    const float gamma = 1.0f - exp2f(-5.0f - (float)h), g127 = exp2f(127.f * l2g), g128 = exp2f(128.f * l2g);
    const bf16_t* Z = (const bf16_t*)(a.ws + WS_Z);
    const float* cs = (const float*)(a.ws + WS_CS);
    const int sc_ = tid >> 2, part = tid & 3, d0 = 16 * part;
    const float dq = exp2f((float)sc_ * l2g), dk = 0.125f * exp2f(-(float)sc_ * l2g);
    __syncthreads();
    for (int e = tid; e < 576; e += NTHREADS) *(LAS u32x4*)(lds + R_ST + e * 16) = (u32x4){0u, 0u, 0u, 0u};
    u32x4 qraw[2], kraw[2], vraw[2]; f32x4 csv[4];
#define RET_PREFETCH(n) do { const size_t pos_ = (size_t)(n) * 128 + sc_; const bf16_t* zr_ = Z + ((size_t)b * SEQ + pos_) * ZW + h * 64 + d0; \
        qraw[0] = *(const u32x4*)(zr_ + ZC_RQ); qraw[1] = *(const u32x4*)(zr_ + ZC_RQ + 8); kraw[0] = *(const u32x4*)(zr_ + ZC_RK); kraw[1] = *(const u32x4*)(zr_ + ZC_RK + 8); \
        vraw[0] = *(const u32x4*)(zr_ + ZC_RV); vraw[1] = *(const u32x4*)(zr_ + ZC_RV + 8); \
        const f32x4* cp_ = (const f32x4*)(cs + (pos_ * 32 + 8 * part) * 2); csv[0] = cp_[0]; csv[1] = cp_[1]; csv[2] = cp_[2]; csv[3] = cp_[3]; } while (0)
    RET_PREFETCH(0);
    f32x16 sacc = (f32x16){};
    const int cl = lane & 31, hi = lane >> 5;
    for (int n = 0; n < SEQ / 128; ++n) {
        {
            u32x4 qo[2], ko[2];
#pragma unroll
            for (int w = 0; w < 8; ++w) {
                const unsigned qw = qraw[w >> 2][w & 3], kw = kraw[w >> 2][w & 3];
                const float cv = csv[w >> 1][(w & 1) * 2], sv = csv[w >> 1][(w & 1) * 2 + 1];
                const float q0 = bf2f(qw & 0xffff), q1 = bf2f(qw >> 16), k0 = bf2f(kw & 0xffff), k1 = bf2f(kw >> 16);
                qo[w >> 2][w & 3] = pg8::cvt_pk_bf16((q0 * cv - q1 * sv) * dq, (q1 * cv + q0 * sv) * dq);
                ko[w >> 2][w & 3] = pg8::cvt_pk_bf16((k0 * cv - k1 * sv) * dk, (k1 * cv + k0 * sv) * dk);
            }
            *(LAS u32x4*)(lds + R_Q + sc_ * KST + d0 * 2) = qo[0]; *(LAS u32x4*)(lds + R_Q + sc_ * KST + d0 * 2 + 16) = qo[1];
            *(LAS u32x4*)(lds + R_K + sc_ * KST + d0 * 2) = ko[0]; *(LAS u32x4*)(lds + R_K + sc_ * KST + d0 * 2 + 16) = ko[1];
            *(LAS u32x4*)(lds + R_V + sc_ * VST + d0 * 2) = vraw[0]; *(LAS u32x4*)(lds + R_V + sc_ * VST + d0 * 2 + 16) = vraw[1];
        }
        __syncthreads();
        if (n + 1 < SEQ / 128) RET_PREFETCH(n + 1);
        const LAS unsigned char* stc = lds + R_ST + (n & 1) * 9216; LAS unsigned char* stn = lds + R_ST + ((n + 1) & 1) * 9216;
        if (wave < 4) {
            const int qc = wave;
            const size_t row = (size_t)b * SEQ + (size_t)n * 128 + 32 * qc + cl;
            u32x2 ggv[8];
            { const bf16_t* grow = Z + row * ZW + ZC_RG + h * 64 + 4 * hi;
#pragma unroll
              for (int i = 0; i < 8; ++i) ggv[i] = *(const u32x2*)(grow + 32 * (i >> 2) + 8 * (i & 3)); }
            bf16x8 qf[4];
#pragma unroll
            for (int ks = 0; ks < 4; ++ks) qf[ks] = *(const LAS bf16x8*)(lds + R_Q + (32 * qc + cl) * KST + (16 * ks + 8 * hi) * 2);
            f32x16 o[2];
#pragma unroll
            for (int et = 0; et < 2; ++et) { f32x16 x = (f32x16){};
#pragma unroll
                for (int ks = 0; ks < 4; ++ks) { const bf16x8 af = *(const LAS bf16x8*)(stc + (32 * et + cl) * KST + (16 * ks + 8 * hi) * 2); x = __builtin_amdgcn_mfma_f32_32x32x16_bf16(af, qf[ks], x, 0, 0, 0); }
#pragma unroll
                for (int r = 0; r < 16; ++r) o[et][r] = gamma * x[r]; }
            for (int mt = 0; mt <= qc; ++mt) {
                f32x16 p = (f32x16){};
#pragma unroll
                for (int ks = 0; ks < 4; ++ks) { const bf16x8 af = *(const LAS bf16x8*)(lds + R_K + (32 * mt + cl) * KST + (16 * ks + 8 * hi) * 2); p = __builtin_amdgcn_mfma_f32_32x32x16_bf16(af, qf[ks], p, 0, 0, 0); }
                if (mt == qc) {
#pragma unroll
                    for (int r = 0; r < 16; ++r) p[r] = (crow(r, hi) <= cl) ? p[r] : 0.f; }
                const LAS unsigned char* vt_ = lds + R_V + 32 * mt * VST;
                pv_step(o, vt_, 0, pack8(p, 0), lane); pv_step(o, vt_, 1, pack8(p, 8), lane);
            }
            float ss = 0.f;
#pragma unroll
            for (int et = 0; et < 2; ++et)
#pragma unroll
                for (int r = 0; r < 16; ++r) ss += o[et][r] * o[et][r];
            ss += __shfl_xor(ss, 32);
            const float rstd = rsqrtf(ss * (1.f / 64.f) + EPS);
            bf16_t* orow = (bf16_t*)(a.ws + WS_MIX) + row * DM + h * 64 + 4 * hi;
#pragma unroll
            for (int et = 0; et < 2; ++et)
#pragma unroll
                for (int gq = 0; gq < 4; ++gq) {
                    const u32x2 gg = ggv[et * 4 + gq];
                    const float ga = bf2f(gg.x & 0xffff), gb = bf2f(gg.x >> 16), gc = bf2f(gg.y & 0xffff), gd = bf2f(gg.y >> 16);
                    u32x2 w;
                    w.x = pg8::cvt_pk_bf16(ga / (1.f + __expf(-ga)) * o[et][4 * gq] * rstd, gb / (1.f + __expf(-gb)) * o[et][4 * gq + 1] * rstd);
                    w.y = pg8::cvt_pk_bf16(gc / (1.f + __expf(-gc)) * o[et][4 * gq + 2] * rstd, gd / (1.f + __expf(-gd)) * o[et][4 * gq + 3] * rstd);
                    if (n + qc + cl != 0) *(u32x2*)(orow + 32 * et + 8 * gq) = w;
                }
        } else {
            const int w4 = wave - 4, et = w4 >> 1, dt = w4 & 1, i = lane & 15, dh = (lane >> 4) & 1;
            f32x16 nw = (f32x16){};
            const LAS unsigned char* pv = lds + R_V + (4 * hi + (i >> 2)) * VST + (32 * et + 16 * dh + 4 * (i & 3)) * 2;
            const LAS unsigned char* pk = lds + R_K + (4 * hi + (i >> 2)) * KST + (32 * dt + 16 * dh + 4 * (i & 3)) * 2;
#pragma unroll
            for (int s8 = 0; s8 < 8; ++s8) {
                const s16x4 al = tr_read(pv + 16 * s8 * VST), ah = tr_read(pv + (16 * s8 + 8) * VST);
                const s16x4 bl = tr_read(pk + 16 * s8 * KST), bh2 = tr_read(pk + (16 * s8 + 8) * KST);
                const bf16x8 af = (bf16x8){al[0], al[1], al[2], al[3], ah[0], ah[1], ah[2], ah[3]}, bfr = (bf16x8){bl[0], bl[1], bl[2], bl[3], bh2[0], bh2[1], bh2[2], bh2[3]};
                nw = __builtin_amdgcn_mfma_f32_32x32x16_bf16(af, bfr, nw, 0, 0, 0);
            }
#pragma unroll
            for (int r = 0; r < 16; ++r) { sacc[r] = g128 * sacc[r] + g127 * nw[r];
                *(LAS bf16_t*)(stn + (32 * et + crow(r, hi)) * KST + (32 * dt + cl) * 2) = (bf16_t)f2bf(sacc[r]); }
        }
        __syncthreads();
    }
#undef RET_PREFETCH
}

constexpr size_t WS_KV = 864 * MiB;
__device__ __forceinline__ float ret_l2g(int h) { return (h == 0) ? -0.04580368961312479f : (h == 1) ? -0.02272007650008353f : (h == 2) ? -0.011315313227834146f : -0.005646563141142062f; }
struct RetRaw { u32x4 q[2], k[2], v[2]; f32x4 cs[4]; };
template <bool WITH_Q> __device__ __forceinline__ void ret_load_chunk(const KArgs& a, int b, int h, int n, int tid, RetRaw& R) {
    const bf16_t* Z = (const bf16_t*)(a.ws + WS_Z); const float* cs = (const float*)(a.ws + WS_CS);
    const int sc_ = tid >> 2, part = tid & 3, d0 = 16 * part;
    const size_t pos = (size_t)n * 128 + sc_; const bf16_t* zr = Z + ((size_t)b * SEQ + pos) * ZW + h * 64 + d0;
    if (WITH_Q) { R.q[0] = *(const u32x4*)(zr + ZC_RQ); R.q[1] = *(const u32x4*)(zr + ZC_RQ + 8); }
    R.k[0] = *(const u32x4*)(zr + ZC_RK); R.k[1] = *(const u32x4*)(zr + ZC_RK + 8); R.v[0] = *(const u32x4*)(zr + ZC_RV); R.v[1] = *(const u32x4*)(zr + ZC_RV + 8);
    const f32x4* cp = (const f32x4*)(cs + (pos * 32 + 8 * part) * 2); R.cs[0] = cp[0]; R.cs[1] = cp[1]; R.cs[2] = cp[2]; R.cs[3] = cp[3];
}
template <bool WITH_Q> __device__ __forceinline__ void ret_store_chunk(const RetRaw& R, int h, LAS unsigned char* lds, int tid) {
    const float l2g = ret_l2g(h);
    const int sc_ = tid >> 2, part = tid & 3, d0 = 16 * part;
    const float dq = exp2f((float)sc_ * l2g), dk = 0.125f * exp2f(-(float)sc_ * l2g);
    u32x4 qo[2], ko[2];
#pragma unroll
    for (int w = 0; w < 8; ++w) {
        const float cv = R.cs[w >> 1][(w & 1) * 2], sv = R.cs[w >> 1][(w & 1) * 2 + 1];
        const unsigned kw = R.k[w >> 2][w & 3]; const float k0 = bf2f(kw & 0xffff), k1 = bf2f(kw >> 16);
        ko[w >> 2][w & 3] = pg8::cvt_pk_bf16((k0 * cv - k1 * sv) * dk, (k1 * cv + k0 * sv) * dk);
        if (WITH_Q) { const unsigned qw = R.q[w >> 2][w & 3]; const float q0 = bf2f(qw & 0xffff), q1 = bf2f(qw >> 16);
            qo[w >> 2][w & 3] = pg8::cvt_pk_bf16((q0 * cv - q1 * sv) * dq, (q1 * cv + q0 * sv) * dq); }
    }
    if (WITH_Q) { *(LAS u32x4*)(lds + R_Q + sc_ * KST + d0 * 2) = qo[0]; *(LAS u32x4*)(lds + R_Q + sc_ * KST + d0 * 2 + 16) = qo[1]; }
    *(LAS u32x4*)(lds + R_K + sc_ * KST + d0 * 2) = ko[0]; *(LAS u32x4*)(lds + R_K + sc_ * KST + d0 * 2 + 16) = ko[1];
    *(LAS u32x4*)(lds + R_V + sc_ * VST + d0 * 2) = R.v[0]; *(LAS u32x4*)(lds + R_V + sc_ * VST + d0 * 2 + 16) = R.v[1];
}
__device__ __forceinline__ void retkv_item(const KArgs& a, int l, int item, int next_item, RetRaw& R, LAS unsigned char* lds, int wave, int lane_in) {
    int lane = lane_in; asm volatile("" : "+v"(lane));
    const int tid = wave * 64 + lane, n = item & 15, bh = item >> 4, h = bh & 3;
    __syncthreads();
    ret_store_chunk<false>(R, h, lds, tid);
    if (next_item >= 0) ret_load_chunk<false>(a, (next_item >> 4) >> 2, (next_item >> 4) & 3, next_item & 15, tid, R);
    __syncthreads();
    if (wave < 4) {
        const int et = wave >> 1, dt = wave & 1, i = lane & 15, dh = (lane >> 4) & 1, hi = lane >> 5, cl = lane & 31;
        f32x16 nw = (f32x16){};
        const LAS unsigned char* pv = lds + R_V + (4 * hi + (i >> 2)) * VST + (32 * et + 16 * dh + 4 * (i & 3)) * 2;
        const LAS unsigned char* pk = lds + R_K + (4 * hi + (i >> 2)) * KST + (32 * dt + 16 * dh + 4 * (i & 3)) * 2;
#pragma unroll
        for (int s8 = 0; s8 < 8; ++s8) {
            const s16x4 al = tr_read(pv + 16 * s8 * VST), ah = tr_read(pv + (16 * s8 + 8) * VST);
            const s16x4 bl = tr_read(pk + 16 * s8 * KST), bh2 = tr_read(pk + (16 * s8 + 8) * KST);
            const bf16x8 af = (bf16x8){al[0], al[1], al[2], al[3], ah[0], ah[1], ah[2], ah[3]}, bfr = (bf16x8){bl[0], bl[1], bl[2], bl[3], bh2[0], bh2[1], bh2[2], bh2[3]};
            nw = __builtin_amdgcn_mfma_f32_32x32x16_bf16(af, bfr, nw, 0, 0, 0);
        }
        float* kv = (float*)(a.ws + WS_KV) + (size_t)item * 4096;
#pragma unroll
        for (int r = 0; r < 16; ++r) kv[(32 * et + crow(r, hi)) * 64 + 32 * dt + cl] = nw[r];
    }
}
__device__ __forceinline__ void retout_item(const KArgs& a, int l, int item, int next_item, RetRaw& R, LAS unsigned char* lds, int wave, int lane_in) {
    int lane = lane_in; asm volatile("" : "+v"(lane));
    const int tid = wave * 64 + lane, n = item & 15, bh = item >> 4, b = bh >> 2, h = bh & 3;
    const float l2g = ret_l2g(h), gamma = 1.0f - exp2f(-5.0f - (float)h);
    const bf16_t* Z = (const bf16_t*)(a.ws + WS_Z);
    __syncthreads();
    {
        const int e = tid >> 3, d8 = (tid & 7) * 8;
        f32x4 s0 = (f32x4){0.f, 0.f, 0.f, 0.f}, s1 = s0;
        const float* kvb = (const float*)(a.ws + WS_KV) + (size_t)(bh * 16) * 4096 + e * 64 + d8;
#pragma unroll 5
        for (int j = 0; j < n; ++j) { const float cf = exp2f(l2g * (float)(128 * (n - 1 - j) + 127));
            const f32x4 x0 = *(const f32x4*)(kvb + (size_t)j * 4096), x1 = *(const f32x4*)(kvb + (size_t)j * 4096 + 4); s0 += cf * x0; s1 += cf * x1; }
        u32x4 w; w.x = pg8::cvt_pk_bf16(s0[0], s0[1]); w.y = pg8::cvt_pk_bf16(s0[2], s0[3]); w.z = pg8::cvt_pk_bf16(s1[0], s1[1]); w.w = pg8::cvt_pk_bf16(s1[2], s1[3]);
        *(LAS u32x4*)(lds + R_ST + e * KST + d8 * 2) = w;
    }
    ret_store_chunk<true>(R, h, lds, tid);
    if (next_item >= 0) ret_load_chunk<true>(a, (next_item >> 4) >> 2, (next_item >> 4) & 3, next_item & 15, tid, R);
    __syncthreads();
    if (wave < 4) {
        const int qc = wave, cl = lane & 31, hi = lane >> 5;
        const LAS unsigned char* stc = lds + R_ST;
        const size_t row = (size_t)b * SEQ + (size_t)n * 128 + 32 * qc + cl;
        u32x2 ggv[8];
        { const bf16_t* grow = Z + row * ZW + ZC_RG + h * 64 + 4 * hi;
#pragma unroll
          for (int i = 0; i < 8; ++i) ggv[i] = *(const u32x2*)(grow + 32 * (i >> 2) + 8 * (i & 3)); }
        bf16x8 qf[4];
#pragma unroll
        for (int ks = 0; ks < 4; ++ks) qf[ks] = *(const LAS bf16x8*)(lds + R_Q + (32 * qc + cl) * KST + (16 * ks + 8 * hi) * 2);
        f32x16 o[2];
#pragma unroll
        for (int et = 0; et < 2; ++et) { f32x16 x = (f32x16){};
#pragma unroll
            for (int ks = 0; ks < 4; ++ks) { const bf16x8 af = *(const LAS bf16x8*)(stc + (32 * et + cl) * KST + (16 * ks + 8 * hi) * 2); x = __builtin_amdgcn_mfma_f32_32x32x16_bf16(af, qf[ks], x, 0, 0, 0); }
#pragma unroll
            for (int r = 0; r < 16; ++r) o[et][r] = gamma * x[r]; }
        for (int mt = 0; mt <= qc; ++mt) {
            f32x16 p = (f32x16){};
#pragma unroll
            for (int ks = 0; ks < 4; ++ks) { const bf16x8 af = *(const LAS bf16x8*)(lds + R_K + (32 * mt + cl) * KST + (16 * ks + 8 * hi) * 2); p = __builtin_amdgcn_mfma_f32_32x32x16_bf16(af, qf[ks], p, 0, 0, 0); }
            if (mt == qc) {
#pragma unroll
                for (int r = 0; r < 16; ++r) p[r] = (crow(r, hi) <= cl) ? p[r] : 0.f; }
            const LAS unsigned char* vt_ = lds + R_V + 32 * mt * VST;
            pv_step(o, vt_, 0, pack8(p, 0), lane); pv_step(o, vt_, 1, pack8(p, 8), lane);
        }
        float ss = 0.f;
#pragma unroll
        for (int et = 0; et < 2; ++et)
#pragma unroll
            for (int r = 0; r < 16; ++r) ss += o[et][r] * o[et][r];
        ss += __shfl_xor(ss, 32);
        const float rstd = rsqrtf(ss * (1.f / 64.f) + EPS);
        bf16_t* orow = (bf16_t*)(a.ws + WS_MIX) + row * DM + h * 64 + 4 * hi;
#pragma unroll
        for (int et = 0; et < 2; ++et)
#pragma unroll
            for (int gq = 0; gq < 4; ++gq) {
                const u32x2 gg = ggv[et * 4 + gq];
                const float ga = bf2f(gg.x & 0xffff), gb = bf2f(gg.x >> 16), gc = bf2f(gg.y & 0xffff), gd = bf2f(gg.y >> 16);
                u32x2 w;
#define SILU_F(x) ((x) * __builtin_amdgcn_rcpf(1.f + __builtin_amdgcn_exp2f(-LOG2E * (x))))
                w.x = pg8::cvt_pk_bf16(SILU_F(ga) * o[et][4 * gq] * rstd, SILU_F(gb) * o[et][4 * gq + 1] * rstd);
                w.y = pg8::cvt_pk_bf16(SILU_F(gc) * o[et][4 * gq + 2] * rstd, SILU_F(gd) * o[et][4 * gq + 3] * rstd);
#undef SILU_F
                if (n + qc + cl != 0) *(u32x2*)(orow + 32 * et + 8 * gq) = w;
            }
    }
}

__device__ __forceinline__ void cmp_mfma_item(const KArgs& a, int l, int item, LAS unsigned char* lds, int wave, int lane_in) {
    int lane = lane_in; asm volatile("" : "+v"(lane));
    const int tid = wave * 64 + lane, kv = item & 1, g = (item >> 1) & 1, b = item >> 2;
    const bf16_t* Z = (const bf16_t*)(a.ws + WS_Z);
    const bf16_t* w1t = (const bf16_t*)(a.ws + WS_W1T) + (size_t)((l * 2 + kv) * 128) * 1024;
    const float* w2 = a.in[kv ? I_W2V : I_W2K] + (size_t)l * 64 * 64;
    const float* cb = (const float*)(a.ws + WS_CB) + (l * 2 + kv) * 64;
    LAS float* Y = (LAS float*)lds;
    LAS float* o1 = Y + 128 * 132;
    LAS float* w2s = o1 + 128 * 64;
    __syncthreads();
    for (int e = tid; e < 1024; e += NTHREADS) *(LAS f32x4*)(w2s + e * 4) = *(const f32x4*)(w2 + e * 4);
    {
        const int mt = wave >> 1, ct0 = (wave & 1) * 2, r = lane & 31, hi = lane >> 5;
        const bf16_t* abase = Z + ((size_t)b * SEQ + 16 * (32 * mt + r)) * ZW + (kv ? ZC_VC : ZC_KC) + g * 64 + 8 * hi;
        const bf16_t* bb0 = w1t + (size_t)(32 * ct0 + r) * 1024 + 8 * hi; const bf16_t* bb1 = bb0 + 32 * 1024;
        f32x16 acc0 = (f32x16){}, acc1 = (f32x16){};
#pragma unroll 8
        for (int ks = 0; ks < 64; ++ks) {
            const bf16x8 af = *(const bf16x8*)(abase + (size_t)(ks >> 2) * ZW + (ks & 3) * 16);
            const bf16x8 b0 = *(const bf16x8*)(bb0 + 16 * ks), b1 = *(const bf16x8*)(bb1 + 16 * ks);
            acc0 = __builtin_amdgcn_mfma_f32_32x32x16_bf16(af, b0, acc0, 0, 0, 0); acc1 = __builtin_amdgcn_mfma_f32_32x32x16_bf16(af, b1, acc1, 0, 0, 0);
        }
#pragma unroll
        for (int rr = 0; rr < 16; ++rr) { const int m = 32 * mt + crow(rr, hi); Y[m * 132 + 32 * ct0 + r] = acc0[rr]; Y[m * 132 + 32 * (ct0 + 1) + r] = acc1[rr]; }
    }
    __syncthreads();
    for (int e = tid; e < 128 * 64; e += NTHREADS) { const int n = e >> 6, j = e & 63;
        float sv = 0.f; if (n < 127) { sv = Y[n * 132 + j] + Y[(n + 1) * 132 + 64 + j] + cb[j]; sv = sv / (1.f + __expf(-sv)); }
        o1[e] = sv; }
    __syncthreads();
    {
        const int n = tid >> 2, jq = (tid & 3) * 16;
        float acc[16];
#pragma unroll
        for (int i = 0; i < 16; ++i) acc[i] = 0.f;
        for (int j = 0; j < 64; ++j) { const float x = o1[n * 64 + j];
#pragma unroll
            for (int q = 0; q < 4; ++q) { const f32x4 w = *(const LAS f32x4*)(w2s + j * 64 + jq + 4 * q); acc[4 * q] += x * w[0]; acc[4 * q + 1] += x * w[1]; acc[4 * q + 2] += x * w[2]; acc[4 * q + 3] += x * w[3]; } }
        if (!kv) { float ss = 0.f;
#pragma unroll
            for (int i = 0; i < 16; ++i) ss += acc[i] * acc[i];
            ss += __shfl_xor(ss, 1); ss += __shfl_xor(ss, 2);
            const float rstd = rsqrtf(ss * (1.f / 64.f) + EPS);
#pragma unroll
            for (int i = 0; i < 16; ++i) acc[i] = acc[i] * rstd * a.in[I_KN][l * 64 + jq + i]; }
        bf16_t* dst = (bf16_t*)(a.ws + (kv ? WS_VCMP : WS_KCMP)) + ((size_t)((b * 2 + g) * 128) + n) * 64 + jq;
        u32x4 w0, w1v;
        w0.x = pk2(acc[0], acc[1]); w0.y = pk2(acc[2], acc[3]); w0.z = pk2(acc[4], acc[5]); w0.w = pk2(acc[6], acc[7]);
        w1v.x = pk2(acc[8], acc[9]); w1v.y = pk2(acc[10], acc[11]); w1v.z = pk2(acc[12], acc[13]); w1v.w = pk2(acc[14], acc[15]);
        if (n >= 127) { w0 = (u32x4){0u, 0u, 0u, 0u}; w1v = w0; }
        *(u32x4*)dst = w0; *(u32x4*)(dst + 8) = w1v;
    }
}

__device__ __forceinline__ void ret0_item(const KArgs& a, int l, int item, LAS unsigned char* lds, int wave, int lane) {
    int tid = threadIdx.x; asm volatile("" : "+v"(tid));
    const int b = item >> 2, hh = item & 3;
    const float* xrow = ((l == 0) ? a.in[I_X] : a.out) + (size_t)b * SEQ * DM;
    const float* gain = a.in[I_NORM_MIX] + l * DM;
    const float* W = a.in[I_W_IN] + (size_t)l * DM * INW;
    LAS float* hs = (LAS float*)lds;
    LAS float* red = hs + 1024;
    LAS float* qk = red + 16;
    __syncthreads();
    float ss = 0.f;
    for (int k = tid; k < DM; k += NTHREADS) { const float xv = xrow[k]; ss += xv * xv; hs[k] = xv * gain[k]; }
    ss = wave_sum(ss);
    if (lane == 0) red[wave] = ss;
    __syncthreads();
    float tot = 0.f;
#pragma unroll
    for (int w = 0; w < 8; ++w) tot += red[w];
    const float rstd = rsqrtf(tot * (1.f / DM) + EPS);
    const int d = tid & 63, which = (tid >> 6) & 1, kp = tid >> 7;
    const float* wc = W + (size_t)(kp * 256) * INW + (which ? ZC_RK : ZC_RQ) + hh * 64 + d;
    float acc0 = 0.f, acc1 = 0.f, acc2 = 0.f, acc3 = 0.f;
    for (int k = 0; k < 256; k += 32) {
        float wv[32];
#pragma unroll
        for (int i = 0; i < 32; ++i) wv[i] = wc[(size_t)(k + i) * INW];
#pragma unroll
        for (int i = 0; i < 32; i += 4) { acc0 += hs[kp * 256 + k + i] * wv[i]; acc1 += hs[kp * 256 + k + i + 1] * wv[i + 1]; acc2 += hs[kp * 256 + k + i + 2] * wv[i + 2]; acc3 += hs[kp * 256 + k + i + 3] * wv[i + 3]; }
    }
    qk[tid] = ((acc0 + acc1) + (acc2 + acc3)) * rstd;
    __syncthreads();
    if (wave == 0) {
        const float q0 = (qk[lane] + qk[128 + lane]) + (qk[256 + lane] + qk[384 + lane]), k0 = (qk[64 + lane] + qk[192 + lane]) + (qk[320 + lane] + qk[448 + lane]);
        const float sdot = wave_sum(q0 * k0) * 0.125f;
        const bf16_t* Z = (const bf16_t*)(a.ws + WS_Z);
        const size_t row = (size_t)b * SEQ;
        const float v = bf2f(Z[row * ZW + ZC_RV + hh * 64 + lane]), g = bf2f(Z[row * ZW + ZC_RG + hh * 64 + lane]);
        const float o = sdot * v;
        const float ro = rsqrtf(wave_sum(o * o) * (1.f / 64.f) + EPS);
        ((bf16_t*)(a.ws + WS_MIX))[row * DM + hh * 64 + lane] = (bf16_t)f2bf(g / (1.f + __expf(-g)) * o * ro);
    }
}

constexpr int N_RET = 128, N_CMP = 128, N_CONV = 256, N_KN = 256, N_R0 = 128;
#ifndef RET_MFMA
#define RET_MFMA 1
#endif
constexpr int N_RKV = 2048, N_ROUT = 2048;
__device__ __forceinline__ int ret_item_of(int i) {
    if (gridDim.x != 256) { const int bh = i >> 4; return (bh << 4) | (((i & 15) + 2 * (bh >> 4)) & 15); }
    const int blk = i & 255, k = i >> 8, x = blk & 7, slot = blk >> 3;
    const int q = 2 * k + (slot >> 4), n = ((slot & 15) + 2 * k) & 15, bh = x + 8 * q;
    return (bh << 4) | n;
}
__device__ __forceinline__ void phase_mix1(const KArgs& a, int l, LAS unsigned char* lds, int wave, int lane, int ci) {
    {
        RetRaw R; const int tid0 = wave * 64 + lane;
        int i = blockIdx.x;
        if (i < N_RKV) { const int it = ret_item_of(i); ret_load_chunk<false>(a, (it >> 4) >> 2, (it >> 4) & 3, it & 15, tid0, R); }
        for (; i < N_RKV; i += gridDim.x) { const int nx = i + gridDim.x; retkv_item(a, l, ret_item_of(i), nx < N_RKV ? ret_item_of(nx) : -1, R, lds, wave, lane); }
    }
    unsigned* ctr = (unsigned*)a.ws + ci;
    LAS int* slot = (LAS int*)(lds + LDS_BYTES - 16);
    for (;;) {
        __syncthreads();
        if (threadIdx.x == 0) *slot = (int)atomicAdd(ctr, 1u);
        __syncthreads();
        int r = *slot;
        if (r >= N_R0 + N_CMP + N_CONV + N_KN) break;
        if (r < N_R0) { ret0_item(a, l, r, lds, wave, lane); continue; } r -= N_R0;
        if (r < N_CMP) { cmp_mfma_item(a, l, r, lds, wave, lane); continue; } r -= N_CMP;
        if (r < N_CONV) { conv_item(a, l, r); continue; } r -= N_CONV;
        knorm_item(a, l, r, wave, lane);
    }
}
__device__ __forceinline__ void phase_retout(const KArgs& a, int l, LAS unsigned char* lds, int wave, int lane, int ci) {
    (void)ci;
    RetRaw R; const int tid0 = wave * 64 + lane;
    int i = blockIdx.x;
    if (i < N_ROUT) { const int it = ret_item_of(i); ret_load_chunk<true>(a, (it >> 4) >> 2, (it >> 4) & 3, it & 15, tid0, R); }
    for (; i < N_ROUT; i += gridDim.x) { const int nx = i + gridDim.x; retout_item(a, l, ret_item_of(i), nx < N_ROUT ? ret_item_of(nx) : -1, R, lds, wave, lane); }
}

#define XB_TMO      128
#define XB_XCNT(j)  (256  + 64 * (j))
#define XB_XSUB(j)  (1280 + 64 * (j))
#define XB_XGEN(j)  (2304 + 64 * (j))
#define XB_TOP      3328
#define XB_TOPGEN   3392
#define XCD_BAR_WORDS 3456
#define XB_SPIN_CAP (1u << 18)
constexpr size_t WS_BAR = 65536;
__device__ __forceinline__ unsigned xb_ld(unsigned* p)              { return __hip_atomic_load(p, __ATOMIC_RELAXED, __HIP_MEMORY_SCOPE_AGENT); }
__device__ __forceinline__ unsigned xb_add(unsigned* p, unsigned v) { return __hip_atomic_fetch_add(p, v, __ATOMIC_RELAXED, __HIP_MEMORY_SCOPE_AGENT); }
__device__ __forceinline__ unsigned xb_xcc_id() { return (unsigned)__builtin_amdgcn_s_getreg((3 << 11) | 20) & 0xFu; }
#define XB_SPIN(cond, bar) do { unsigned _sp = 0; while (cond) { __builtin_amdgcn_s_sleep(1); \
    if ((++_sp & 255u) == 0u) { if (xb_ld(&(bar)[XB_TMO])) break; if (_sp > XB_SPIN_CAP) { atomicAdd(&(bar)[XB_TMO], 1u); break; } } } } while (0)
struct XcdBarrier { unsigned* bar; unsigned x; volatile LAS unsigned* st; };
__device__ __forceinline__ XcdBarrier xcd_barrier_post(unsigned* bar, volatile LAS unsigned* st) {
    XcdBarrier b; b.bar = bar; b.x = xb_xcc_id(); b.st = st;
    if (threadIdx.x == 0) (void)xb_add(&bar[XB_XCNT(b.x)], 1u);
    return b;
}
__device__ __forceinline__ void xcd_barrier_complete(unsigned* bar, unsigned x, unsigned& nloc, unsigned& nx) {
    const unsigned G = gridDim.x * gridDim.y * gridDim.z;
    unsigned sum, cnt, mine, sp = 0u;
    for (;;) {
        sum = 0u; cnt = 0u; mine = 0u;
#pragma unroll
        for (unsigned j = 0; j < 16; ++j) { const unsigned c = xb_ld(&bar[XB_XCNT(j)]); sum += c; cnt += (c > 0u) ? 1u : 0u; mine = (j == x) ? c : mine; }
        if (sum == G) break;
        __builtin_amdgcn_s_sleep(1);
        if ((++sp & 255u) == 0u) { if (xb_ld(&bar[XB_TMO])) break; if (sp > XB_SPIN_CAP) { atomicAdd(&bar[XB_TMO], 1u); break; } }
    }
    nloc = mine > 0u ? mine : 1u; nx = cnt > 0u ? cnt : 1u;
}
__device__ __forceinline__ void xcd_barrier(const XcdBarrier& b) {
    asm volatile("s_waitcnt vmcnt(0)" ::: "memory");
    __syncthreads();
    if (threadIdx.x == 0) {
        unsigned* bar = b.bar;
        __builtin_amdgcn_s_waitcnt(0);
        unsigned nloc = b.st[0], nx = b.st[1];
        if (nloc == 0u) { xcd_barrier_complete(bar, b.x, nloc, nx); b.st[0] = nloc; b.st[1] = nx; }
        const unsigned old = xb_add(&bar[XB_XSUB(b.x)], 1u);
        const unsigned gen = old / nloc;
        if (old + 1u == (gen + 1u) * nloc) {
            __builtin_amdgcn_fence(__ATOMIC_RELEASE, "agent");
            asm volatile("s_waitcnt vmcnt(0)" ::: "memory");
            const unsigned og = xb_add(&bar[XB_TOP], 1u);
            const unsigned tg = og / nx;
            if (og + 1u == (tg + 1u) * nx) xb_add(&bar[XB_TOPGEN], 1u);
            else XB_SPIN(xb_ld(&bar[XB_TOPGEN]) == tg, bar);
            __builtin_amdgcn_fence(__ATOMIC_ACQUIRE, "agent");
            xb_add(&bar[XB_XGEN(b.x)], 1u);
            asm volatile("s_waitcnt vmcnt(0)" ::: "memory");
        } else {
            XB_SPIN(xb_ld(&bar[XB_XGEN(b.x)]) == gen, bar);
            __builtin_amdgcn_fence(__ATOMIC_ACQUIRE, "agent");
            asm volatile("s_waitcnt vmcnt(0)" ::: "memory");
        }
    }
    __syncthreads();
}

constexpr int N_PHASES = 1 + 6 * DEPTH;
#ifndef NSA_MFMA
#define NSA_MFMA 1
#endif

#define PH_IN(k) (lo <= (k) && (k) < hi)
#define PH_SEAM(k) do { if (PH_IN(k) && PH_IN((k) + 1)) { xcd_barrier(xbar); if (PROBE & 16) xcd_barrier(xbar); } } while (0)
#define PH_TID() int tid = threadIdx.x; asm volatile("" : "+v"(tid)); const int lane = tid & 63, wave = __builtin_amdgcn_readfirstlane(tid >> 6); (void)lane; (void)wave
template <int L> __device__ __forceinline__ void layer_phases(const KArgs& a, LAS unsigned char* lds, const XcdBarrier& xbar, int lo, int hi) {
    unsigned char* ws = a.ws;
    bf16_t* XB = (bf16_t*)(ws + WS_XN); bf16_t* Zb = (bf16_t*)(ws + WS_Z); bf16_t* Hb = (bf16_t*)(ws + WS_H); bf16_t* MIXb = (bf16_t*)(ws + WS_MIX); float* SSQ = (float*)(ws + WS_SSQ);
    const int G = gridDim.x; constexpr int l = L, P0 = 1 + 6 * L;
    const float* xcur = (l == 0) ? a.in[I_X] : a.out;
    if (PH_IN(P0 + 0)) {
        pg8::Gemm g{XB, (const bf16_t*)(ws + WS_WIN) + (size_t)l * ZW * DM, MTOK, ZW, DM}; pg8::StaticOrder S; S.init(MTOK, ZW, G, (int)blockIdx.x);
        pg8::EpiBf16<0> E{Zb, ZW, SSQ};
        pg8::gemm_phase<pg8::EpiBf16<0>, pg8::StaticOrder, true, true>(lds, g, S, E);
    }
    PH_SEAM(P0 + 0);
    if (PH_IN(P0 + 1)) { PH_TID(); phase_mix1(a, l, lds, wave, lane, l); }
    PH_SEAM(P0 + 1);
    if (PH_IN(P0 + 2)) { PH_TID(); phase_nsa2(a, l, lds, wave, lane); phase_retout(a, l, lds, wave, lane, 4 + l); }
    PH_SEAM(P0 + 2);
    if (PH_IN(P0 + 3)) {
        pg8::Gemm g{MIXb, (const bf16_t*)(ws + WS_WOUT) + (size_t)l * DM * DM, MTOK, DM, DM}; pg8::StaticOrder S; S.init(MTOK, DM, G, (int)blockIdx.x);
        pg8::EpiRes E{xcur, a.out, DM, XB, SSQ};
        pg8::gemm_phase<pg8::EpiRes, pg8::StaticOrder, true, true>(lds, g, S, E);
    }
    PH_SEAM(P0 + 3);
    if (PH_IN(P0 + 4)) {
        pg8::Gemm g{XB, (const bf16_t*)(ws + WS_WUP) + (size_t)l * FF * DM, MTOK, FF, DM}; pg8::StaticOrder S; S.init(MTOK, FF, G, (int)blockIdx.x);
        pg8::EpiBf16<1> E{Hb, FF, SSQ};
        pg8::gemm_phase<pg8::EpiBf16<1>, pg8::StaticOrder, true, true>(lds, g, S, E);
    }
    PH_SEAM(P0 + 4);
    if (PH_IN(P0 + 5)) {
        pg8::Gemm g{Hb, (const bf16_t*)(ws + WS_WDN) + (size_t)l * DM * FF, MTOK, DM, FF}; pg8::StaticOrder S; S.init(MTOK, DM, G, (int)blockIdx.x);
        pg8::EpiRes E{a.out, a.out, DM, (l + 1 < DEPTH) ? XB : nullptr, SSQ};
        pg8::gemm_phase<pg8::EpiRes, pg8::StaticOrder, true, true>(lds, g, S, E);
    }
    PH_SEAM(P0 + 5);
}
__global__ void __launch_bounds__(NTHREADS, 2) fwd_kernel(KArgs a) {
    extern __shared__ __attribute__((aligned(16))) unsigned char lds_raw[];
    LAS unsigned char* lds = (LAS unsigned char*)lds_raw;
    cg::grid_group grid = cg::this_grid();
    const int lo = a.ph_lo, hi = a.ph_hi;
    volatile LAS unsigned* xst = (volatile LAS unsigned*)(lds + LDS_BYTES - 32);
    if (threadIdx.x < 2) xst[threadIdx.x] = 0u;
    unsigned* barw = (unsigned*)(a.ws + WS_BAR);
    {
        PH_TID();
        if (blockIdx.x == 0) {
            if (tid < 64) ((unsigned*)a.ws)[tid] = 0u;
            for (int e = tid; e < XCD_BAR_WORDS; e += NTHREADS) barw[e] = 0u;
        }
        phase_prologue(a, lds, wave, lane);
        if (PROBE & 32) phase_prologue(a, lds, wave, lane);
        phase_xcvt(a.in[I_X], (bf16_t*)(a.ws + WS_XN), (float*)(a.ws + WS_SSQ), wave, lane);
    }
    __syncthreads(); grid.sync();
    const XcdBarrier xbar = xcd_barrier_post(barw, xst);
    layer_phases<0>(a, lds, xbar, lo, hi);
    layer_phases<1>(a, lds, xbar, lo, hi);
}

extern "C" void kernel_launch(void* const* d_in, const int* in_sizes, int n_in, void* d_out, int out_size, void* d_ws, size_t ws_size, hipStream_t stream) {
    static int grid = 0;
    if (grid == 0) {
        if (n_in != 16 || in_sizes[0] != MTOK * DM || out_size != MTOK * DM || ws_size < WS_END) {
            fprintf(stderr, "kernel_launch: unexpected shapes (n_in %d, in0 %d, out %d, ws %zu)\n", n_in, n_in > 0 ? in_sizes[0] : -1, out_size, ws_size); grid = -1; return; }
        int dev = 0, cus = 0, per_cu = 0;
        hipGetDevice(&dev); hipDeviceGetAttribute(&cus, hipDeviceAttributeMultiprocessorCount, dev);
        hipFuncSetAttribute((const void*)fwd_kernel, hipFuncAttributeMaxDynamicSharedMemorySize, LDS_BYTES);
        hipOccupancyMaxActiveBlocksPerMultiprocessor(&per_cu, (const void*)fwd_kernel, NTHREADS, LDS_BYTES);
        if (per_cu < 1) { fprintf(stderr, "kernel_launch: occupancy query says %d blocks per CU\n", per_cu); per_cu = 1; }
        (void)hipGetLastError();
        grid = cus * 1;
    }
    if (grid < 0) return;
    KArgs a{};
    for (int i = 0; i < 16; ++i) a.in[i] = (const float*)d_in[i];
    a.out = (float*)d_out; a.ws = (unsigned char*)d_ws; a.ph_lo = 0; a.ph_hi = N_PHASES;
    void* args[] = {&a};
    hipError_t e = hipLaunchCooperativeKernel((const void*)fwd_kernel, dim3(grid), dim3(NTHREADS), args, LDS_BYTES, stream);
    if (e != hipSuccess) fprintf(stderr, "cooperative launch failed: %s (grid %d)\n", hipGetErrorString(e), grid);
}
```
